# Optimizing an MI355X kernel written in HIP

```python
import jax
import jax.numpy as jnp
from jax import lax
import numpy as np

D_MODEL = 2048
BATCH = 8
SEQ = 2048
DEPTH = 1

HEAD_DIM = 128
NSA_WIDTH = D_MODEL // 2
NSA_HEADS = NSA_WIDTH // HEAD_DIM
NSA_KV_HEADS = max(1, NSA_HEADS // 4)
NSA_GROUP = NSA_HEADS // NSA_KV_HEADS
CMP_LEN = 32
CMP_STRIDE = 16
SLC_LEN = 64
N_SELECT = 16
FORCED_SCORE = 1e4
WINDOW = 512
WIN_BLOCK = 128
SLC_Q_CHUNK = 32
RNN_WIDTH = D_MODEL - NSA_WIDTH
RNN_BLOCKS = RNN_WIDTH // HEAD_DIM
RNN_BLOCK_DIM = RNN_WIDTH // RNN_BLOCKS
CONV_WIDTH = 4
LRU_C = 8.0
PEER_HEADS = 8
PEER_KEYS = 128
PEER_EXPERTS = PEER_KEYS * PEER_KEYS
PEER_TOPK = 16
PEER_DQ = 256
PEER_TOK_CHUNK = 128
ROPE_THETA = 10000.0
EPS = 1e-6

Q_COLS = NSA_HEADS * HEAD_DIM
KV_COLS = NSA_KV_HEADS * HEAD_DIM
GATE_COLS = 3 * NSA_HEADS
N_IN = Q_COLS + 6 * KV_COLS + GATE_COLS + 2 * RNN_WIDTH

kernel_name = 'hybrid_nsa_rglru_peer_adaln'


def rms_norm(x, g):
    x32 = x.astype(jnp.float32)
    y = x32 * lax.rsqrt(jnp.mean(x32 * x32, axis=-1, keepdims=True) + EPS)
    return (y * g.astype(jnp.float32)).astype(x.dtype)


def rope(x, pos):
    half = x.shape[-1] // 2
    freqs = ROPE_THETA ** (-jnp.arange(half, dtype=jnp.float32) / half)
    ang = pos.astype(jnp.float32)[:, None] * freqs[None, :]
    cos = jnp.cos(ang)[:, None, :]
    sin = jnp.sin(ang)[:, None, :]
    x32 = x.astype(jnp.float32)
    x1, x2 = x32[..., :half], x32[..., half:]
    return jnp.concatenate([x1 * cos - x2 * sin, x2 * cos + x1 * sin], axis=-1).astype(x.dtype)


def masked_softmax(s, mask):
    s = jnp.where(mask, s.astype(jnp.float32), -jnp.inf)
    m = jnp.max(s, axis=-1, keepdims=True)
    m = jnp.where(jnp.isfinite(m), m, 0.0)
    p = jnp.exp(s - m)
    d = jnp.sum(p, axis=-1, keepdims=True)
    return p / jnp.where(d > 0, d, 1.0)


def compress_blocks(k, pe, w):
    B, S, G, dh = k.shape
    n_cmp = (S - CMP_LEN) // CMP_STRIDE + 1
    idx = (jnp.arange(n_cmp) * CMP_STRIDE)[:, None] + jnp.arange(CMP_LEN)[None, :]
    blk = k[:, idx] + pe[None, None, :, None, :]
    blk = jnp.transpose(blk, (0, 3, 1, 2, 4)).reshape(B, G, n_cmp, CMP_LEN * dh)
    return blk @ w


def nsa_attention(q, kc, vc, ks, vs, kw, vw, gates):
    B, G, S, R, dh = q.shape
    scale = dh ** -0.5
    t = jnp.arange(S)
    n_cmp = kc.shape[2]
    cmp_start = jnp.arange(n_cmp) * CMP_STRIDE
    mask_c = (cmp_start + CMP_LEN - 1)[None, :] <= t[:, None]
    p_c = masked_softmax(jnp.einsum('bgsrd,bgcd->bgsrc', q, kc) * scale, mask_c[None, None, :, None, :])
    o_cmp = jnp.einsum('bgsrc,bgcd->bgsrd', p_c.astype(vc.dtype), vc)
    n_slc = S // SLC_LEN
    slc_start = jnp.arange(n_slc) * SLC_LEN
    overlap = jnp.maximum(
        jnp.minimum(cmp_start[:, None] + CMP_LEN, slc_start[None, :] + SLC_LEN)
        - jnp.maximum(cmp_start[:, None], slc_start[None, :]), 0).astype(jnp.float32) / CMP_LEN
    imp = jnp.einsum('bgsrc,cj->bgsj', p_c, overlap)
    cur = t // SLC_LEN
    jb = jnp.arange(n_slc)
    forced = (jb[None, :] == 0) | (jb[None, :] == cur[:, None]) | (jb[None, :] == cur[:, None] - 1)
    valid = slc_start[None, :] <= t[:, None]
    imp = jnp.where(forced, FORCED_SCORE, jnp.where(valid, imp, -FORCED_SCORE))
    n_sel = min(N_SELECT, n_slc)
    _, sel = lax.top_k(imp, n_sel)
    kb = ks.reshape(B, G, n_slc, SLC_LEN, dh)
    vb = vs.reshape(B, G, n_slc, SLC_LEN, dh)
    nq = S // SLC_Q_CHUNK
    q_chunks = jnp.moveaxis(q.reshape(B, G, nq, SLC_Q_CHUNK, R, dh), 2, 0)
    sel_chunks = jnp.moveaxis(sel.reshape(B, G, nq, SLC_Q_CHUNK, n_sel), 2, 0)
    t_chunks = t.reshape(nq, SLC_Q_CHUNK)
    bi = jnp.arange(B)[:, None, None, None]
    gi = jnp.arange(G)[None, :, None, None]
    n_key = n_sel * SLC_LEN

    def slc_chunk(args):
        q_i, sel_i, t_i = args
        kg = kb[bi, gi, sel_i].reshape(B, G, SLC_Q_CHUNK, n_key, dh)
        vg = vb[bi, gi, sel_i].reshape(B, G, SLC_Q_CHUNK, n_key, dh)
        kpos = (sel_i[..., None] * SLC_LEN + jnp.arange(SLC_LEN)).reshape(B, G, SLC_Q_CHUNK, n_key)
        mask = (kpos <= t_i[None, None, :, None])[:, :, :, None, :]
        p = masked_softmax(jnp.einsum('bgqrd,bgqkd->bgqrk', q_i, kg) * scale, mask)
        return jnp.einsum('bgqrk,bgqkd->bgqrd', p.astype(vg.dtype), vg)

    o_slc = lax.map(slc_chunk, (q_chunks, sel_chunks, t_chunks))
    o_slc = jnp.moveaxis(o_slc, 0, 2).reshape(B, G, S, R, dh)
    nb = S // WIN_BLOCK
    npre = WINDOW // WIN_BLOCK
    pad = ((0, 0), (0, 0), (WINDOW, 0), (0, 0))
    kp = jnp.pad(kw, pad).reshape(B, G, nb + npre, WIN_BLOCK, dh)
    vp = jnp.pad(vw, pad).reshape(B, G, nb + npre, WIN_BLOCK, dh)
    kband = jnp.concatenate([kp[:, :, i:i + nb] for i in range(npre + 1)], axis=3)
    vband = jnp.concatenate([vp[:, :, i:i + nb] for i in range(npre + 1)], axis=3)
    qw = q.reshape(B, G, nb, WIN_BLOCK, R, dh)
    qi = jnp.arange(WIN_BLOCK)
    kj = jnp.arange((npre + 1) * WIN_BLOCK)
    rel = kj[None, :] - WINDOW - qi[:, None]
    kabs = (jnp.arange(nb) * WIN_BLOCK)[:, None] + kj[None, :] - WINDOW
    mask_w = ((rel <= 0) & (rel > -WINDOW))[None, :, :] & (kabs >= 0)[:, None, :]
    p_w = masked_softmax(jnp.einsum('bgnqrd,bgnkd->bgnqrk', qw, kband) * scale,
                         mask_w[None, None, :, :, None, :])
    o_win = jnp.einsum('bgnqrk,bgnkd->bgnqrd', p_w.astype(vband.dtype), vband).reshape(B, G, S, R, dh)
    return gates[..., 0:1] * o_cmp + gates[..., 1:2] * o_slc + gates[..., 2:3] * o_win


def rglru_branch(xr, xg, conv_w, conv_b, wa, ba, wi, bi, lam):
    B, S, W = xr.shape
    xp = jnp.pad(xr, ((0, 0), (CONV_WIDTH - 1, 0), (0, 0)))
    u = conv_b + sum(xp[:, i:i + S] * conv_w[i] for i in range(CONV_WIDTH))
    ub = u.reshape(B, S, RNN_BLOCKS, RNN_BLOCK_DIM)
    r = jax.nn.sigmoid((jnp.einsum('bsnd,nde->bsne', ub, wa).reshape(B, S, W) + ba).astype(jnp.float32))
    ig = jax.nn.sigmoid((jnp.einsum('bsnd,nde->bsne', ub, wi).reshape(B, S, W) + bi).astype(jnp.float32))
    log_a = -LRU_C * r * jax.nn.softplus(-lam.astype(jnp.float32))
    a = jnp.exp(log_a)
    b = jnp.sqrt(-jnp.expm1(2.0 * log_a)) * ig * u.astype(jnp.float32)

    def combine(left, right):
        a1, b1 = left
        a2, b2 = right
        return a1 * a2, a2 * b1 + b2

    _, hs = lax.associative_scan(combine, (a, b), axis=1)
    return (jax.nn.gelu(xg.astype(jnp.float32), approximate=False) * hs).astype(xr.dtype)


def hybrid_mixer(h, w_in, w_out, q_norm_g, k_norm_g, cmp_pe_k, cmp_pe_v, cmp_w_k, cmp_w_v, gate_b,
                 conv_w, conv_b, lru_wa, lru_ba, lru_wi, lru_bi, lru_lam, out_g_attn, out_g_rnn):
    B, S, _ = h.shape
    G, R, dh = NSA_KV_HEADS, NSA_GROUP, HEAD_DIM
    z = h @ w_in
    cuts = [int(v) for v in np.cumsum([Q_COLS] + [KV_COLS] * 6 + [GATE_COLS, RNN_WIDTH])]
    q, kc, vc, ks, vs, kw, vw, gl, xr, xg = jnp.split(z, cuts, axis=-1)
    pos = jnp.arange(S)
    q = rope(rms_norm(q.reshape(B, S, NSA_HEADS, dh), q_norm_g), pos)
    kc = rms_norm(compress_blocks(rope(kc.reshape(B, S, G, dh), pos), cmp_pe_k, cmp_w_k), k_norm_g[0])
    vc = compress_blocks(vc.reshape(B, S, G, dh), cmp_pe_v, cmp_w_v)
    ks = rope(rms_norm(ks.reshape(B, S, G, dh), k_norm_g[1]), pos)
    kw = rope(rms_norm(kw.reshape(B, S, G, dh), k_norm_g[2]), pos)
    qg = q.reshape(B, S, G, R, dh).transpose(0, 2, 1, 3, 4)
    gates = jax.nn.sigmoid(gl + gate_b).reshape(B, S, G, R, 3).transpose(0, 2, 1, 3, 4)
    o_attn = nsa_attention(qg, kc, vc,
                           jnp.swapaxes(ks, 1, 2), jnp.swapaxes(vs.reshape(B, S, G, dh), 1, 2),
                           jnp.swapaxes(kw, 1, 2), jnp.swapaxes(vw.reshape(B, S, G, dh), 1, 2), gates)
    o_attn = o_attn.transpose(0, 2, 1, 3, 4).reshape(B, S, NSA_WIDTH)
    o_rnn = rglru_branch(xr, xg, conv_w, conv_b, lru_wa, lru_ba, lru_wi, lru_bi, lru_lam)
    y = jnp.concatenate([rms_norm(o_attn, out_g_attn), rms_norm(o_rnn, out_g_rnn)], axis=-1)
    return y @ w_out


def peer_ffn(h, wq, keys, down, up):
    B, S, D = h.shape
    T = B * S
    hf = h.reshape(T, D)
    q = (hf @ wq).reshape(T, PEER_HEADS, 2, PEER_DQ // 2)
    s = jnp.einsum('thpd,hpkd->thpk', q, keys).astype(jnp.float32)
    v1, i1 = lax.top_k(s[:, :, 0], PEER_TOPK)
    v2, i2 = lax.top_k(s[:, :, 1], PEER_TOPK)
    cand = (v1[..., :, None] + v2[..., None, :]).reshape(T, PEER_HEADS, PEER_TOPK * PEER_TOPK)
    cidx = (i1[..., :, None] * PEER_KEYS + i2[..., None, :]).reshape(T, PEER_HEADS, PEER_TOPK * PEER_TOPK)
    vals, pick = lax.top_k(cand, PEER_TOPK)
    eidx = jnp.take_along_axis(cidx, pick, axis=-1)
    g = jax.nn.softmax(vals, axis=-1)
    nc = T // PEER_TOK_CHUNK

    def chunk(args):
        x_c, e_c, g_c = args
        act = jax.nn.gelu(jnp.einsum('td,thkd->thk', x_c, down[e_c]).astype(jnp.float32),
                          approximate=False) * g_c
        return jnp.einsum('thk,thkd->td', act.astype(up.dtype), up[e_c])

    out = lax.map(chunk, (hf.reshape(nc, PEER_TOK_CHUNK, D),
                          eidx.reshape(nc, PEER_TOK_CHUNK, PEER_HEADS, PEER_TOPK),
                          g.reshape(nc, PEER_TOK_CHUNK, PEER_HEADS, PEER_TOPK)))
    return out.reshape(B, S, D).astype(h.dtype)


def setup_inputs(seed: int = 0) -> dict:
    key = jax.random.key(seed)
    ks = jax.random.split(key, 32)
    f32 = jnp.float32
    L = DEPTH

    def nrm(k, shape, s):
        return jax.random.normal(k, shape, f32) * s

    u = jax.random.uniform(ks[26], (L, RNN_WIDTH), f32, 0.9, 0.999)
    return {
        'x': nrm(ks[0], (BATCH, SEQ, D_MODEL), 1.0),
        'c': nrm(ks[1], (BATCH, D_MODEL), 1.0),
        'ada_w': nrm(ks[2], (L, D_MODEL, 6 * D_MODEL), 0.5 * D_MODEL ** -0.5),
        'ada_b': nrm(ks[3], (L, 6 * D_MODEL), 0.02),
        'norm_mix_g': 1.0 + nrm(ks[4], (L, D_MODEL), 0.02),
        'norm_ffn_g': 1.0 + nrm(ks[5], (L, D_MODEL), 0.02),
        'w_in': nrm(ks[6], (L, D_MODEL, N_IN), D_MODEL ** -0.5),
        'w_out': nrm(ks[7], (L, NSA_WIDTH + RNN_WIDTH, D_MODEL), (NSA_WIDTH + RNN_WIDTH) ** -0.5),
        'q_norm_g': 1.0 + nrm(ks[8], (L, HEAD_DIM), 0.02),
        'k_norm_g': 1.0 + nrm(ks[9], (L, 3, HEAD_DIM), 0.02),
        'cmp_pe_k': nrm(ks[10], (L, CMP_LEN, HEAD_DIM), 0.02),
        'cmp_pe_v': nrm(ks[11], (L, CMP_LEN, HEAD_DIM), 0.02),
        'cmp_w_k': nrm(ks[12], (L, CMP_LEN * HEAD_DIM, HEAD_DIM), (CMP_LEN * HEAD_DIM) ** -0.5),
        'cmp_w_v': nrm(ks[13], (L, CMP_LEN * HEAD_DIM, HEAD_DIM), (CMP_LEN * HEAD_DIM) ** -0.5),
        'gate_b': nrm(ks[14], (L, GATE_COLS), 0.1),
        'conv_w': nrm(ks[15], (L, CONV_WIDTH, RNN_WIDTH), CONV_WIDTH ** -0.5),
        'conv_b': nrm(ks[16], (L, RNN_WIDTH), 0.02),
        'lru_wa': nrm(ks[17], (L, RNN_BLOCKS, RNN_BLOCK_DIM, RNN_BLOCK_DIM), RNN_BLOCK_DIM ** -0.5),
        'lru_ba': nrm(ks[18], (L, RNN_WIDTH), 0.1),
        'lru_wi': nrm(ks[19], (L, RNN_BLOCKS, RNN_BLOCK_DIM, RNN_BLOCK_DIM), RNN_BLOCK_DIM ** -0.5),
        'lru_bi': nrm(ks[20], (L, RNN_WIDTH), 0.1),
        'lru_lam': jnp.log(u) - jnp.log1p(-u),
        'out_g_attn': 1.0 + nrm(ks[21], (L, NSA_WIDTH), 0.02),
        'out_g_rnn': 1.0 + nrm(ks[22], (L, RNN_WIDTH), 0.02),
        'peer_wq': nrm(ks[23], (L, D_MODEL, PEER_HEADS * PEER_DQ), D_MODEL ** -0.5),
        'peer_keys': nrm(ks[24], (L, PEER_HEADS, 2, PEER_KEYS, PEER_DQ // 2), (PEER_DQ // 2) ** -0.5),
        'peer_down': nrm(ks[25], (L, PEER_EXPERTS, D_MODEL), D_MODEL ** -0.5),
        'peer_up': nrm(ks[27], (L, PEER_EXPERTS, D_MODEL), PEER_HEADS ** -0.5),
    }


def reference(x, c, ada_w, ada_b, norm_mix_g, norm_ffn_g, w_in, w_out, q_norm_g, k_norm_g,
              cmp_pe_k, cmp_pe_v, cmp_w_k, cmp_w_v, gate_b, conv_w, conv_b, lru_wa, lru_ba,
              lru_wi, lru_bi, lru_lam, out_g_attn, out_g_rnn, peer_wq, peer_keys, peer_down, peer_up):
    for l in range(DEPTH):
        mod = jax.nn.silu(c) @ ada_w[l] + ada_b[l]
        sh1, sc1, gt1, sh2, sc2, gt2 = jnp.split(mod, 6, axis=-1)
        h = rms_norm(x, norm_mix_g[l]) * (1 + sc1[:, None]) + sh1[:, None]
        x = x + gt1[:, None] * hybrid_mixer(
            h, w_in[l], w_out[l], q_norm_g[l], k_norm_g[l], cmp_pe_k[l], cmp_pe_v[l], cmp_w_k[l],
            cmp_w_v[l], gate_b[l], conv_w[l], conv_b[l], lru_wa[l], lru_ba[l], lru_wi[l], lru_bi[l],
            lru_lam[l], out_g_attn[l], out_g_rnn[l])
        h = rms_norm(x, norm_ffn_g[l]) * (1 + sc2[:, None]) + sh2[:, None]
        x = x + gt2[:, None] * peer_ffn(h, peer_wq[l], peer_keys[l], peer_down[l], peer_up[l])
    return x
```

```cpp
#include <hip/hip_runtime.h>
#include <hip/hip_cooperative_groups.h>
#include <cstdio>
#include <cstdint>
namespace cg = cooperative_groups;

typedef unsigned short u16;
using bf16x8 = __attribute__((ext_vector_type(8))) short;
using f32x4 = __attribute__((ext_vector_type(4))) float;
using u16x4 = __attribute__((ext_vector_type(4))) unsigned short;
using u32x2 = __attribute__((ext_vector_type(2))) unsigned;
using u32x4 = __attribute__((ext_vector_type(4))) unsigned;

#define DEV __device__ __forceinline__

constexpr int S_ = 2048, D_ = 2048, B_ = 8, T_ = B_ * S_;
constexpr int NIN = 4632, ZLD = 4736;
constexpr int CQ = 0, CKC = 1024, CVC = 1280, CKS = 1536, CVS = 1792, CKW = 2048, CVW = 2304, CGL = 2560, CXR = 2584, CXG = 3608;
constexpr int SMEM_BYTES = 73728 + 256;
constexpr float QSCALE = 0.08838834764831845f * 1.4426950408889634f;
constexpr int NCH = 64;
constexpr int CHL = 32;

struct Params {
  const float *x, *c, *ada_w, *ada_b, *norm_mix_g, *norm_ffn_g, *w_in, *w_out, *q_norm_g, *k_norm_g;
  const float *cmp_pe_k, *cmp_pe_v, *cmp_w_k, *cmp_w_v, *gate_b, *conv_w, *conv_b, *lru_wa, *lru_ba;
  const float *lru_wi, *lru_bi, *lru_lam, *out_g_attn, *out_g_rnn, *peer_wq, *peer_keys, *peer_down, *peer_up;
  float* out;
  u16 *Wt_in, *Wt_out, *Wt_q, *Wt_ck, *Wt_cv, *Wt_g;
  float *cbias, *modpart, *mod;
  u16 *h, *oattn3, *z, *vsT, *vwT, *vcT, *kcmp, *U;
  float *a_arr, *b_arr, *csA, *csH;
  u16 *orn, *y, *pq;
  unsigned char *down8, *up8;
  int* eidx; float* gw;
  unsigned* bar;
  float* rope_tab;
  u16* pe_b;
  float* cpart;
  u16* keys_b;
};

DEV int ltid() { int t = threadIdx.x; asm volatile("" : "+v"(t)); return t; }
typedef float float2v __attribute__((ext_vector_type(2)));
typedef __bf16 bf16x2v __attribute__((ext_vector_type(2)));
DEV u16 f2bf(float f) { return __builtin_bit_cast(u16, (__bf16)f); }
DEV float bf2f(u16 h) { return __uint_as_float(((unsigned)h) << 16); }
DEV unsigned pack2(float a, float b) { float2v v = {a, b}; return __builtin_bit_cast(unsigned, __builtin_convertvector(v, bf16x2v)); }
DEV float bflo(unsigned u) { return __uint_as_float(u << 16); }
DEV float bfhi(unsigned u) { return __uint_as_float(u & 0xffff0000u); }
DEV float wave_sum(float v) {
#pragma unroll
  for (int o = 32; o; o >>= 1) v += __shfl_xor(v, o);
  return v;
}
DEV float sigmoidf_(float v) { return 1.f / (1.f + __expf(-v)); }
DEV float gelu_exact(float v) { return 0.5f * v * (1.f + erff(v * 0.7071067811865476f)); }

DEV void ph_modpart(const Params& p, int item, float* sm) {
  const int cb = item % 12, kc = item / 12, tid = ltid();
  for (int i = tid; i < 512; i += 256) {
    int b = i >> 6, k = i & 63;
    float v = p.c[b * 2048 + kc * 64 + k];
    sm[i] = v / (1.f + __expf(-v));
  }
  __syncthreads();
  const int col = cb * 1024 + tid * 4;
  float acc[8][4];
#pragma unroll
  for (int b = 0; b < 8; ++b) { acc[b][0] = acc[b][1] = acc[b][2] = acc[b][3] = 0.f; }
  const float* w = p.ada_w + (size_t)(kc * 64) * 12288 + col;
#pragma unroll 4
  for (int k = 0; k < 64; ++k) {
    float4 wv = *(const float4*)(w + (size_t)k * 12288);
#pragma unroll
    for (int b = 0; b < 8; ++b) {
      float s = sm[b * 64 + k];
      acc[b][0] += s * wv.x; acc[b][1] += s * wv.y; acc[b][2] += s * wv.z; acc[b][3] += s * wv.w;
    }
  }
#pragma unroll
  for (int b = 0; b < 8; ++b)
    *(float4*)(p.modpart + ((size_t)(kc * 8 + b)) * 12288 + col) = make_float4(acc[b][0], acc[b][1], acc[b][2], acc[b][3]);
  __syncthreads();
}

DEV void ph_transpose(const float* src, int K, int N, int Npad, u16* dst, int item, float* sm) {
  const int ntl = Npad / 64, kt = item / ntl, nti = item % ntl, tid = ltid();
  const int c4 = tid & 15, r0 = tid >> 4;
  float4 v[4];
#pragma unroll
  for (int ps = 0; ps < 4; ++ps) {
    const int k = ps * 16 + r0, n = nti * 64 + c4 * 4;
    v[ps] = (n < N) ? *(const float4*)(src + (size_t)(kt * 64 + k) * N + n) : make_float4(0.f, 0.f, 0.f, 0.f);
  }
#pragma unroll
  for (int ps = 0; ps < 4; ++ps) {
    const int k = ps * 16 + r0;
    sm[k * 65 + c4 * 4 + 0] = v[ps].x; sm[k * 65 + c4 * 4 + 1] = v[ps].y; sm[k * 65 + c4 * 4 + 2] = v[ps].z; sm[k * 65 + c4 * 4 + 3] = v[ps].w;
  }
  __syncthreads();
  {
    const int n = tid >> 2, q = tid & 3;
    u32x4 o0, o1;
#pragma unroll
    for (int e = 0; e < 4; ++e) {
      o0[e] = pack2(sm[(q * 16 + 2 * e) * 65 + n], sm[(q * 16 + 2 * e + 1) * 65 + n]);
      o1[e] = pack2(sm[(q * 16 + 8 + 2 * e) * 65 + n], sm[(q * 16 + 8 + 2 * e + 1) * 65 + n]);
    }
    u16* d = dst + (size_t)(nti * 64 + n) * K + kt * 64 + q * 16;
    *(u32x4*)d = o0; *(u32x4*)(d + 8) = o1;
  }
  __syncthreads();
}

DEV void ph_cbias(const Params& p, int which, float* sm) {
  const float* pe = which ? p.cmp_pe_v : p.cmp_pe_k;
  const float* W = which ? p.cmp_w_v : p.cmp_w_k;
  const int tid = ltid(), n = tid & 127, hf = tid >> 7;
  float acc = 0.f;
  for (int k = hf * 2048; k < hf * 2048 + 2048; ++k) acc += pe[k] * W[(size_t)k * 128 + n];
  sm[tid] = acc;
  __syncthreads();
  if (tid < 128) p.cbias[which * 128 + tid] = sm[tid] + sm[tid + 128];
  __syncthreads();
}

DEV void ph_adaln_row(const float* xin, const float* g, const float* mod, int sh_off, int sc_off, u16* hout, int row) {
  const int lane = ltid() & 63, b = row >> 11;
  const float* xr = xin + (size_t)row * 2048;
  float4 v[8];
  float ss = 0.f;
#pragma unroll
  for (int i = 0; i < 8; ++i) {
    v[i] = *(const float4*)(xr + i * 256 + lane * 4);
    ss += v[i].x * v[i].x + v[i].y * v[i].y + v[i].z * v[i].z + v[i].w * v[i].w;
  }
  ss = wave_sum(ss);
  const float rstd = rsqrtf(ss * (1.f / 2048.f) + 1e-6f);
  const float* mb = mod + (size_t)b * 12288;
#pragma unroll
  for (int i = 0; i < 8; ++i) {
    int col = i * 256 + lane * 4;
    float4 g4 = *(const float4*)(g + col);
    float4 sc = *(const float4*)(mb + sc_off + col);
    float4 sh = *(const float4*)(mb + sh_off + col);
    float y0 = v[i].x * rstd * g4.x * (1.f + sc.x) + sh.x;
    float y1 = v[i].y * rstd * g4.y * (1.f + sc.y) + sh.y;
    float y2 = v[i].z * rstd * g4.z * (1.f + sc.z) + sh.z;
    float y3 = v[i].w * rstd * g4.w * (1.f + sc.w) + sh.w;
    u32x2 pk; pk[0] = pack2(y0, y1); pk[1] = pack2(y2, y3);
    *(u32x2*)(hout + (size_t)row * 2048 + col) = pk;
  }
}

template <class AF, class EPI>
DEV void gemm_tile(AF aptr, const u16* Bt, int ldb, int K, EPI epi, char* smem) {
  const int tid = ltid(), wid = tid >> 6, lane = tid & 63, wr = wid >> 1, wc = wid & 1, fr = lane & 15, fq = lane >> 4;
  f32x4 acc[4][4];
#pragma unroll
  for (int m = 0; m < 4; ++m)
#pragma unroll
    for (int n = 0; n < 4; ++n) acc[m][n] = f32x4{0.f, 0.f, 0.f, 0.f};
  const int nk = K / 32;
  auto stage = [&](int kt, int buf) {
    char* SA = smem + buf * 16384;
    char* SB = SA + 8192;
#pragma unroll
    for (int i = 0; i < 2; ++i) {
      int bo = tid * 16 + i * 4096, r = bo >> 6, c = (bo & 63) >> 1;
      __builtin_amdgcn_global_load_lds((const unsigned*)aptr(r, kt * 32 + c), (__attribute__((address_space(3))) unsigned*)(SA + bo), 16, 0, 0);
      __builtin_amdgcn_global_load_lds((const unsigned*)(Bt + (size_t)r * ldb + kt * 32 + c), (__attribute__((address_space(3))) unsigned*)(SB + bo), 16, 0, 0);
    }
  };
  asm volatile("s_waitcnt vmcnt(0)" ::: "memory");
  __syncthreads();
  stage(0, 0);
  if (nk > 1) stage(1, 1);
  if (nk > 2) stage(2, 2);
  const unsigned lbase = (unsigned)(size_t)(const __attribute__((address_space(3))) char*)smem;
  const unsigned aoff = lbase + (wr * 64 + fr) * 64 + fq * 16, boff = lbase + 8192 + (wc * 64 + fr) * 64 + fq * 16;
  for (int t = 0; t < nk; ++t) {
    if (t + 2 < nk) asm volatile("s_waitcnt vmcnt(8)" ::: "memory");
    else if (t + 1 < nk) asm volatile("s_waitcnt vmcnt(4)" ::: "memory");
    else asm volatile("s_waitcnt vmcnt(0)" ::: "memory");
    __builtin_amdgcn_s_barrier();
    if (t + 3 < nk) stage(t + 3, (t + 3) & 3);
    const unsigned sa = aoff + (t & 3) * 16384, sb = boff + (t & 3) * 16384;
    u32x4 a0, a1, a2, a3, b0, b1, b2, b3;
    asm volatile("ds_read_b128 %0, %1" : "=v"(a0) : "v"(sa));
    asm volatile("ds_read_b128 %0, %1" : "=v"(b0) : "v"(sb));
    asm volatile("ds_read_b128 %0, %1 offset:1024" : "=v"(b1) : "v"(sb));
    asm volatile("ds_read_b128 %0, %1 offset:2048" : "=v"(b2) : "v"(sb));
    asm volatile("ds_read_b128 %0, %1 offset:3072" : "=v"(b3) : "v"(sb));
    asm volatile("ds_read_b128 %0, %1 offset:1024" : "=v"(a1) : "v"(sa));
    asm volatile("ds_read_b128 %0, %1 offset:2048" : "=v"(a2) : "v"(sa));
    asm volatile("ds_read_b128 %0, %1 offset:3072" : "=v"(a3) : "v"(sa));
    asm volatile("s_waitcnt lgkmcnt(0)" : "+v"(a0), "+v"(a1), "+v"(a2), "+v"(a3), "+v"(b0), "+v"(b1), "+v"(b2), "+v"(b3));
    bf16x8 At[4], Bv[4];
    At[0] = __builtin_bit_cast(bf16x8, a0); At[1] = __builtin_bit_cast(bf16x8, a1); At[2] = __builtin_bit_cast(bf16x8, a2); At[3] = __builtin_bit_cast(bf16x8, a3);
    Bv[0] = __builtin_bit_cast(bf16x8, b0); Bv[1] = __builtin_bit_cast(bf16x8, b1); Bv[2] = __builtin_bit_cast(bf16x8, b2); Bv[3] = __builtin_bit_cast(bf16x8, b3);
#pragma unroll
    for (int m = 0; m < 4; ++m)
#pragma unroll
      for (int n = 0; n < 4; ++n) acc[m][n] = __builtin_amdgcn_mfma_f32_16x16x32_bf16(At[m], Bv[n], acc[m][n], 0, 0, 0);
  }
  __syncthreads();
  {
    int fr2 = fr, fq2 = fq;
    asm volatile("" : "+v"(fr2), "+v"(fq2));
    epi(acc, wr, wc, fr2, fq2);
  }
}

template <class AF, class EPI>
DEV void gemm_tile256(AF aptr, const u16* Bt, int ldb, int K, EPI epi, char* smem) {
  const int tid = ltid(), wid = tid >> 6, lane = tid & 63, wr = wid >> 1, wc = wid & 1, fr = lane & 15, fq = lane >> 4;
  f32x4 acc[8][4];
#pragma unroll
  for (int m = 0; m < 8; ++m)
#pragma unroll
    for (int n = 0; n < 4; ++n) acc[m][n] = f32x4{0.f, 0.f, 0.f, 0.f};
  const int nk = K / 32;
  auto stage = [&](int kt, int buf) {
    char* SA = smem + buf * 24576;
    char* SB = SA + 16384;
#pragma unroll
    for (int i = 0; i < 4; ++i) {
      int bo = tid * 16 + i * 4096, r = bo >> 6, c = (bo & 63) >> 1;
      __builtin_amdgcn_global_load_lds((const unsigned*)aptr(r, kt * 32 + c), (__attribute__((address_space(3))) unsigned*)(SA + bo), 16, 0, 0);
    }
#pragma unroll
    for (int i = 0; i < 2; ++i) {
      int bo = tid * 16 + i * 4096, r = bo >> 6, c = (bo & 63) >> 1;
      __builtin_amdgcn_global_load_lds((const unsigned*)(Bt + (size_t)r * ldb + kt * 32 + c), (__attribute__((address_space(3))) unsigned*)(SB + bo), 16, 0, 0);
    }
  };
  asm volatile("s_waitcnt vmcnt(0)" ::: "memory");
  __syncthreads();
  stage(0, 0);
  stage(1, 1);
  const unsigned lbase = (unsigned)(size_t)(const __attribute__((address_space(3))) char*)smem;
  const unsigned aoff = lbase + (wr * 128 + fr) * 64 + fq * 16, boff = lbase + 16384 + (wc * 64 + fr) * 64 + fq * 16;
  int buf = 0;
#pragma unroll 1
  for (int t = 0; t < nk; ++t) {
    if (t + 1 < nk) asm volatile("s_waitcnt vmcnt(6)" ::: "memory");
    else asm volatile("s_waitcnt vmcnt(0)" ::: "memory");
    __builtin_amdgcn_s_barrier();
    if (t + 2 < nk) { int nb2 = buf + 2; if (nb2 >= 3) nb2 -= 3; stage(t + 2, nb2); }
    const unsigned sa = aoff + buf * 24576, sb = boff + buf * 24576;
    u32x4 a0, a1, a2, a3, a4, a5, a6, a7, b0, b1, b2, b3;
    asm volatile("ds_read_b128 %0, %1" : "=v"(b0) : "v"(sb));
    asm volatile("ds_read_b128 %0, %1 offset:1024" : "=v"(b1) : "v"(sb));
    asm volatile("ds_read_b128 %0, %1 offset:2048" : "=v"(b2) : "v"(sb));
    asm volatile("ds_read_b128 %0, %1 offset:3072" : "=v"(b3) : "v"(sb));
    asm volatile("ds_read_b128 %0, %1" : "=v"(a0) : "v"(sa));
    asm volatile("ds_read_b128 %0, %1 offset:1024" : "=v"(a1) : "v"(sa));
    asm volatile("ds_read_b128 %0, %1 offset:2048" : "=v"(a2) : "v"(sa));
    asm volatile("ds_read_b128 %0, %1 offset:3072" : "=v"(a3) : "v"(sa));
    asm volatile("ds_read_b128 %0, %1 offset:4096" : "=v"(a4) : "v"(sa));
    asm volatile("ds_read_b128 %0, %1 offset:5120" : "=v"(a5) : "v"(sa));
    asm volatile("ds_read_b128 %0, %1 offset:6144" : "=v"(a6) : "v"(sa));
    asm volatile("ds_read_b128 %0, %1 offset:7168" : "=v"(a7) : "v"(sa));
    asm volatile("s_waitcnt lgkmcnt(4)" : "+v"(a0), "+v"(a1), "+v"(a2), "+v"(a3), "+v"(b0), "+v"(b1), "+v"(b2), "+v"(b3));
    bf16x8 Bv[4];
    Bv[0] = __builtin_bit_cast(bf16x8, b0); Bv[1] = __builtin_bit_cast(bf16x8, b1); Bv[2] = __builtin_bit_cast(bf16x8, b2); Bv[3] = __builtin_bit_cast(bf16x8, b3);
    {
      bf16x8 At[4];
      At[0] = __builtin_bit_cast(bf16x8, a0); At[1] = __builtin_bit_cast(bf16x8, a1); At[2] = __builtin_bit_cast(bf16x8, a2); At[3] = __builtin_bit_cast(bf16x8, a3);
#pragma unroll
      for (int m = 0; m < 4; ++m)
#pragma unroll
        for (int n = 0; n < 4; ++n) acc[m][n] = __builtin_amdgcn_mfma_f32_16x16x32_bf16(At[m], Bv[n], acc[m][n], 0, 0, 0);
    }
    asm volatile("s_waitcnt lgkmcnt(0)" : "+v"(a4), "+v"(a5), "+v"(a6), "+v"(a7));
    {
      bf16x8 At[4];
      At[0] = __builtin_bit_cast(bf16x8, a4); At[1] = __builtin_bit_cast(bf16x8, a5); At[2] = __builtin_bit_cast(bf16x8, a6); At[3] = __builtin_bit_cast(bf16x8, a7);
#pragma unroll
      for (int m = 0; m < 4; ++m)
#pragma unroll
        for (int n = 0; n < 4; ++n) acc[4 + m][n] = __builtin_amdgcn_mfma_f32_16x16x32_bf16(At[m], Bv[n], acc[4 + m][n], 0, 0, 0);
    }
    buf = (buf == 2) ? 0 : buf + 1;
  }
  __syncthreads();
  {
    int fr2 = fr, fq2 = fq;
    asm volatile("" : "+v"(fr2), "+v"(fq2));
#pragma unroll
    for (int h = 0; h < 2; ++h) {
      auto stager = [&](float* smf_, int STR) {
        if (wr == h) {
#pragma unroll
          for (int m = 0; m < 8; ++m)
#pragma unroll
            for (int n = 0; n < 4; ++n)
#pragma unroll
              for (int j = 0; j < 4; ++j) smf_[(m * 16 + fq2 * 4 + j) * STR + wc * 64 + n * 16 + fr2] = acc[m][n][j];
        }
      };
      epi(stager, h);
    }
  }
}

DEV void ph_post_token(const Params& p, int row) {
  const int lane = ltid() & 63, pos = row & 2047;
  const float freq = exp2f(-(float)lane * (13.287712379549449f / 64.f));
  float sn, cs;
  sincosf((float)pos * freq, &sn, &cs);
  u16* zr = p.z + (size_t)row * ZLD;
  auto seg = [&](int col, const float* gn, float osc) {
    float x1 = bf2f(zr[col + lane]), x2 = bf2f(zr[col + 64 + lane]);
    if (gn) {
      float ss = wave_sum(x1 * x1 + x2 * x2);
      float r = rsqrtf(ss * (1.f / 128.f) + 1e-6f);
      x1 *= r * gn[lane]; x2 *= r * gn[lane + 64];
    }
    float o1 = x1 * cs - x2 * sn, o2 = x2 * cs + x1 * sn;
    zr[col + lane] = f2bf(o1 * osc); zr[col + 64 + lane] = f2bf(o2 * osc);
  };
  for (int hh = 0; hh < 8; ++hh) seg(CQ + hh * 128, p.q_norm_g, QSCALE);
  for (int g = 0; g < 2; ++g) {
    seg(CKC + g * 128, nullptr, 1.f);
    seg(CKS + g * 128, p.k_norm_g + 128, 1.f);
    seg(CKW + g * 128, p.k_norm_g + 256, 1.f);
  }
  const int ch0 = lane * 16;
  float u[16];
#pragma unroll
  for (int e = 0; e < 16; ++e) u[e] = p.conv_b[ch0 + e];
#pragma unroll
  for (int i = 0; i < 4; ++i) {
    int tt = pos - 3 + i;
    if (tt >= 0) {
      const u16* src = p.z + (size_t)(row - 3 + i) * ZLD + CXR + ch0;
      u32x4 a = *(const u32x4*)src, b2 = *(const u32x4*)(src + 8);
      const float* w = p.conv_w + i * 1024 + ch0;
#pragma unroll
      for (int e = 0; e < 4; ++e) {
        u[2 * e] += bflo(a[e]) * w[2 * e]; u[2 * e + 1] += bfhi(a[e]) * w[2 * e + 1];
        u[8 + 2 * e] += bflo(b2[e]) * w[8 + 2 * e]; u[8 + 2 * e + 1] += bfhi(b2[e]) * w[8 + 2 * e + 1];
      }
    }
  }
  u32x4 o0, o1;
#pragma unroll
  for (int e = 0; e < 4; ++e) { o0[e] = pack2(u[2 * e], u[2 * e + 1]); o1[e] = pack2(u[8 + 2 * e], u[8 + 2 * e + 1]); }
  u16* dst = p.U + (size_t)row * 1024 + ch0;
  *(u32x4*)dst = o0; *(u32x4*)(dst + 8) = o1;
}

template <int STR>
DEV void stage_acc_s(float* smf, f32x4 (&acc)[4][4], int wr, int wc, int fr, int fq) {
#pragma unroll
  for (int m = 0; m < 4; ++m)
#pragma unroll
    for (int n = 0; n < 4; ++n)
#pragma unroll
      for (int j = 0; j < 4; ++j) smf[(wr * 64 + m * 16 + fq * 4 + j) * STR + wc * 64 + n * 16 + fr] = acc[m][n][j];
}
DEV void stage_acc(float* smf, f32x4 (&acc)[4][4], int wr, int wc, int fr, int fq) {
#pragma unroll
  for (int m = 0; m < 4; ++m)
#pragma unroll
    for (int n = 0; n < 4; ++n)
#pragma unroll
      for (int j = 0; j < 4; ++j) smf[(wr * 64 + m * 16 + fq * 4 + j) * 129 + wc * 64 + n * 16 + fr] = acc[m][n][j];
}
DEV void store_row_bf16(const float* srow, u16* dst) {
#pragma unroll
  for (int q = 0; q < 8; ++q) {
    u32x4 o;
#pragma unroll
    for (int e = 0; e < 4; ++e) o[e] = pack2(srow[q * 8 + 2 * e], srow[q * 8 + 2 * e + 1]);
    *(u32x4*)(dst + q * 8) = o;
  }
}

DEV void ph_conv_tokens(const Params& p, int tok0) {
  const int lane = ltid() & 63, ch0 = lane * 16, pos0 = tok0 & 2047;
  float cw[4][16], cb[16];
#pragma unroll
  for (int q = 0; q < 4; ++q) {
    float4 v = *(const float4*)(p.conv_b + ch0 + q * 4);
    cb[q * 4] = v.x; cb[q * 4 + 1] = v.y; cb[q * 4 + 2] = v.z; cb[q * 4 + 3] = v.w;
#pragma unroll
    for (int i = 0; i < 4; ++i) {
      float4 w = *(const float4*)(p.conv_w + i * 1024 + ch0 + q * 4);
      cw[i][q * 4] = w.x; cw[i][q * 4 + 1] = w.y; cw[i][q * 4 + 2] = w.z; cw[i][q * 4 + 3] = w.w;
    }
  }
  u32x4 rows[11][2];
#pragma unroll
  for (int i = 0; i < 11; ++i) {
    const bool ok = (pos0 - 3 + i) >= 0;
    const u16* src = p.z + (size_t)(tok0 - 3 + i) * ZLD + CXR + ch0;
    rows[i][0] = ok ? *(const u32x4*)src : u32x4{0u, 0u, 0u, 0u};
    rows[i][1] = ok ? *(const u32x4*)(src + 8) : u32x4{0u, 0u, 0u, 0u};
  }
#pragma unroll
  for (int tk = 0; tk < 8; ++tk) {
    float u[16];
#pragma unroll
    for (int e = 0; e < 16; ++e) u[e] = cb[e];
#pragma unroll
    for (int i = 0; i < 4; ++i)
#pragma unroll
      for (int hh = 0; hh < 2; ++hh)
#pragma unroll
        for (int e = 0; e < 4; ++e) {
          const unsigned v = rows[tk + i][hh][e];
          u[hh * 8 + 2 * e] += bflo(v) * cw[i][hh * 8 + 2 * e];
          u[hh * 8 + 2 * e + 1] += bfhi(v) * cw[i][hh * 8 + 2 * e + 1];
        }
    u32x4 o0, o1;
#pragma unroll
    for (int e = 0; e < 4; ++e) { o0[e] = pack2(u[2 * e], u[2 * e + 1]); o1[e] = pack2(u[8 + 2 * e], u[8 + 2 * e + 1]); }
    u16* dst = p.U + (size_t)(tok0 + tk) * 1024 + ch0;
    *(u32x4*)dst = o0; *(u32x4*)(dst + 8) = o1;
  }
}

DEV void ph_vtrans(const Params& p, int item, char* smem) {
  const int tid = ltid();
  const int tt = item & 31, which = (item >> 5) & 1, bg = item >> 6, b = bg >> 1, g = bg & 1;
  u16* sm = (u16*)smem;
  const u16* src = p.z + (size_t)(b * S_ + tt * 64) * ZLD + (which ? CVW : CVS) + g * 128;
  __syncthreads();
#pragma unroll
  for (int i = 0; i < 4; ++i) {
    int id = tid + i * 256, r = id >> 4, c16 = id & 15;
    u32x4 v = *(const u32x4*)(src + (size_t)r * ZLD + c16 * 8);
    *(u32x4*)(sm + r * 136 + c16 * 8) = v;
  }
  __syncthreads();
  u16* dstb = (which ? p.vwT : p.vsT) + (size_t)bg * 128 * S_ + tt * 64;
#pragma unroll
  for (int i = 0; i < 4; ++i) {
    int id = tid + i * 256, d = id >> 3, c8 = id & 7;
    u32x4 o;
#pragma unroll
    for (int e = 0; e < 4; ++e) {
      unsigned lo = sm[(c8 * 8 + 2 * e) * 136 + d], hi = sm[(c8 * 8 + 2 * e + 1) * 136 + d];
      o[e] = lo | (hi << 16);
    }
    *(u32x4*)(dstb + (size_t)d * S_ + c8 * 8) = o;
  }
}

DEV bf16x8 pack_p(const f32x4& a, const f32x4& b) {
  u32x4 r;
  r[0] = pack2(a[0], a[1]); r[1] = pack2(a[2], a[3]); r[2] = pack2(b[0], b[1]); r[3] = pack2(b[2], b[3]);
  return __builtin_bit_cast(bf16x8, r);
}
DEV bf16x8 ld2x64(const u16* p0, const u16* p1) {
  u32x2 a = *(const u32x2*)p0, b = *(const u32x2*)p1;
  u32x4 r; r[0] = a[0]; r[1] = a[1]; r[2] = b[0]; r[3] = b[1];
  return __builtin_bit_cast(bf16x8, r);
}

DEV void attn_item(const Params& p, int item, char* smem) {
  int tid_ = threadIdx.x;
  asm volatile("" : "+v"(tid_));
  const int tid = tid_, lane = tid & 63, w = __builtin_amdgcn_readfirstlane(tid >> 6), lq = lane & 15, g4 = lane >> 4;
  const int bg = item & 15, qt32 = 63 - (item >> 4), b = bg >> 1, g = bg & 1;
  const int t0 = qt32 * 32, cur = t0 >> 6, hq = g * 4 + w;
  u16* Ks = (u16*)smem;
  u16* Vs = (u16*)(smem + 34816);
  float* impP = (float*)smem;
  float* impT = (float*)(smem + 34816);
  unsigned* selmask = (unsigned*)(smem + 69632);
  const u16* zb = p.z + (size_t)(b * S_) * ZLD;
  const float NEG_INF = -__builtin_inff();

  bf16x8 qf[2][4];
#pragma unroll
  for (int qt = 0; qt < 2; ++qt)
#pragma unroll
    for (int ks = 0; ks < 4; ++ks)
      qf[qt][ks] = *(const bf16x8*)(zb + (size_t)(t0 + qt * 16 + lq) * ZLD + CQ + hq * 128 + ks * 32 + g4 * 8);
  auto gatef = [&](int qt, int br) -> float {
    return sigmoidf_(bf2f(zb[(size_t)(t0 + qt * 16 + lq) * ZLD + CGL + hq * 3 + br]) + p.gate_b[hq * 3 + br]);
  };

  __builtin_amdgcn_sched_barrier(0);
  const size_t orow0 = (size_t)(b * S_ + t0 + lq) * 1024 + hq * 128 + g4 * 4;
  const bool need_sel = (cur >= 16);

  __syncthreads();
  {
    const u16* ksrc = p.kcmp + (size_t)bg * 128 * 128;
    const u16* vsrc = p.vcT + (size_t)bg * 128 * 128;
#pragma unroll
    for (int i = 0; i < 8; ++i) {
      int id = tid + i * 256, r = id >> 4, c16 = id & 15;
      *(u32x4*)(Ks + r * 136 + c16 * 8) = *(const u32x4*)(ksrc + r * 128 + c16 * 8);
      *(u32x4*)(Vs + r * 136 + c16 * 8) = *(const u32x4*)(vsrc + r * 128 + c16 * 8);
    }
    if (tid < 64) selmask[tid] = (tid == 33) ? 0xFFFFFFFFu : 0u;
  }
  __syncthreads();
  float impown[2][8];
#pragma unroll
  for (int qt = 0; qt < 2; ++qt) {
    __builtin_amdgcn_sched_barrier(0);
    f32x4 s[8];
#pragma unroll
    for (int kt = 0; kt < 8; ++kt) s[kt] = f32x4{0.f, 0.f, 0.f, 0.f};
#pragma unroll
    for (int kt = 0; kt < 8; ++kt)
#pragma unroll
      for (int ks = 0; ks < 4; ++ks) {
        bf16x8 a = *(const bf16x8*)(Ks + (kt * 16 + lq) * 136 + ks * 32 + g4 * 8);
        s[kt] = __builtin_amdgcn_mfma_f32_16x16x32_bf16(a, qf[qt][ks], s[kt], 0, 0, 0);
      }
    const int t = t0 + qt * 16 + lq;
    int cmax = (t >= 31) ? ((t - 31) >> 4) : -1;
    if (cmax > 126) cmax = 126;
    float mx = NEG_INF;
#pragma unroll
    for (int kt = 0; kt < 8; ++kt)
#pragma unroll
      for (int j = 0; j < 4; ++j) {
        int c = kt * 16 + g4 * 4 + j;
        float v = (c <= cmax) ? s[kt][j] : NEG_INF;
        s[kt][j] = v; mx = fmaxf(mx, v);
      }
    mx = fmaxf(mx, __shfl_xor(mx, 16)); mx = fmaxf(mx, __shfl_xor(mx, 32));
    const float mu = (mx == NEG_INF) ? 0.f : mx;
    float sum = 0.f;
#pragma unroll
    for (int kt = 0; kt < 8; ++kt)
#pragma unroll
      for (int j = 0; j < 4; ++j) { float pv = exp2f(s[kt][j] - mu); s[kt][j] = pv; sum += pv; }
    sum += __shfl_xor(sum, 16); sum += __shfl_xor(sum, 32);
    const float inv = (sum > 0.f) ? 1.f / sum : 0.f;
#pragma unroll
    for (int kt = 0; kt < 8; ++kt)
#pragma unroll
      for (int j = 0; j < 4; ++j) s[kt][j] *= inv;
    float spl[8];
#pragma unroll
    for (int kt = 0; kt < 8; ++kt) spl[kt] = 0.5f * s[kt][3];
#pragma unroll
    for (int kt = 0; kt < 8; ++kt) {
      float own = s[kt][0] + s[kt][1] + s[kt][2] + spl[kt];
      float up = __shfl(spl[kt], (lane + 48) & 63);
      float upprev = (kt > 0) ? __shfl(spl[kt > 0 ? kt - 1 : 0], (lane + 48) & 63) : 0.f;
      impown[qt][kt] = own + (g4 ? up : upprev);
    }
    __builtin_amdgcn_sched_barrier(0);
    f32x4 o[8];
#pragma unroll
    for (int dt = 0; dt < 8; ++dt) o[dt] = f32x4{0.f, 0.f, 0.f, 0.f};
#pragma unroll
    for (int m = 0; m < 4; ++m) {
      bf16x8 pb = pack_p(s[2 * m], s[2 * m + 1]);
#pragma unroll
      for (int dt = 0; dt < 8; ++dt) {
        const u16* vr = Vs + (dt * 16 + lq) * 136 + 32 * m + 4 * g4;
        bf16x8 a = ld2x64(vr, vr + 16);
        o[dt] = __builtin_amdgcn_mfma_f32_16x16x32_bf16(a, pb, o[dt], 0, 0, 0);
      }
    }
    __builtin_amdgcn_sched_barrier(0);
    u16* od = p.oattn3 + orow0 + (size_t)qt * 16 * 1024;
    const float gc = gatef(qt, 0);
#pragma unroll
    for (int dt = 0; dt < 8; ++dt) {
      u32x2 pk; pk[0] = pack2(o[dt][0] * gc, o[dt][1] * gc); pk[1] = pack2(o[dt][2] * gc, o[dt][3] * gc);
      *(u32x2*)(od + dt * 16) = pk;
    }
  }
  __syncthreads();
  if (need_sel) {
#pragma unroll
    for (int qt = 0; qt < 2; ++qt)
#pragma unroll
      for (int kt = 0; kt < 8; ++kt) impP[(w * 32 + qt * 16 + lq) * 32 + kt * 4 + g4] = impown[qt][kt];
  }
  __syncthreads();
  {
    const int q = tid >> 3, sub = tid & 7;
    if (need_sel) {
#pragma unroll
      for (int jj = 0; jj < 4; ++jj) {
        int j = sub * 4 + jj;
        impT[q * 32 + j] = impP[(0 * 32 + q) * 32 + j] + impP[(1 * 32 + q) * 32 + j] + impP[(2 * 32 + q) * 32 + j] + impP[(3 * 32 + q) * 32 + j];
      }
    }
    __syncthreads();
    unsigned m = 0u;
    if (!need_sel) {
      if (sub == 0) m = (cur + 1 >= 32) ? 0xffffffffu : ((1u << (cur + 1)) - 1u);
    } else {
      for (int jj = 0; jj < 4; ++jj) {
        int j = sub * 4 + jj;
        bool forced = (j == 0) || (j == cur) || (j == cur - 1);
        if (forced) { m |= 1u << j; continue; }
        if (j < 1 || j > cur - 2) continue;
        float mine = impT[q * 32 + j];
        int rank = 0;
        for (int j2 = 1; j2 <= cur - 2; ++j2) {
          float o2 = impT[q * 32 + j2];
          rank += (o2 > mine || (o2 == mine && j2 < j)) ? 1 : 0;
        }
        if (rank < 13) m |= 1u << j;
      }
    }
    if (m) { atomicOr(&selmask[q], m); atomicOr(&selmask[32], m); }
  }
  __syncthreads();
  if (tid < 32) atomicAnd(&selmask[33], selmask[tid]);
  __syncthreads();
  const unsigned umask = selmask[32], amask = selmask[33];
  const unsigned smq0 = selmask[lq], smq1 = selmask[16 + lq];

#pragma unroll 1
  for (int br = 1; br <= 2; ++br) {
    f32x4 o[2][8];
#pragma unroll
    for (int qt = 0; qt < 2; ++qt)
#pragma unroll
      for (int dt = 0; dt < 8; ++dt) o[qt][dt] = f32x4{0.f, 0.f, 0.f, 0.f};
    float lrun[2] = {0.f, 0.f};
    float Mb;
    {
      const float* kg = p.k_norm_g + br * 128;
      float gq = fmaxf(fabsf(p.q_norm_g[lane]), fabsf(p.q_norm_g[lane + 64]));
      float gk = fmaxf(fabsf(kg[lane]), fabsf(kg[lane + 64]));
#pragma unroll
      for (int o2 = 32; o2; o2 >>= 1) { gq = fmaxf(gq, __shfl_xor(gq, o2)); gk = fmaxf(gk, __shfl_xor(gk, o2)); }
      Mb = 128.f * QSCALE * gq * gk * 1.02f;
    }
    int jlo = 0;
    if (br == 2) { jlo = (t0 >= 511) ? ((t0 - 511) >> 6) : 0; }
    const int kcol = (br == 1 ? CKS : CKW) + g * 128;
    const u16* vT = (br == 1 ? p.vsT : p.vwT) + (size_t)bg * 128 * S_;
    u32x4 kreg[4], vreg[4];
    auto tload = [&](int jj) {
#pragma unroll
      for (int i = 0; i < 4; ++i) {
        int id = tid + i * 256;
        int r = id >> 4, c16 = id & 15;
        kreg[i] = *(const u32x4*)(zb + (size_t)(jj * 64 + r) * ZLD + kcol + c16 * 8);
        int d = id >> 3, c8 = id & 7;
        vreg[i] = *(const u32x4*)(vT + (size_t)d * S_ + jj * 64 + c8 * 8);
      }
    };
    tload(jlo);
    int j = jlo;
#pragma unroll 1
    while (j <= cur) {
      __syncthreads();
#pragma unroll
      for (int i = 0; i < 4; ++i) {
        int id = tid + i * 256;
        int r = id >> 4, c16 = id & 15;
        *(u32x4*)(Ks + r * 136 + c16 * 8) = kreg[i];
        int d = id >> 3, c8 = id & 7;
        *(u32x4*)(Vs + d * 72 + c8 * 8) = vreg[i];
      }
      __syncthreads();
      int jn = j + 1;
      if (br == 1) { const unsigned mm = (j >= 31) ? 0u : (umask >> (j + 1)); jn = mm ? (j + 1 + __builtin_ctz(mm)) : (cur + 1); }
      if (jn <= cur) tload(jn);
      const int jcur = j;
      const bool need_mask = (jcur == cur) || (br == 1 ? !((amask >> jcur) & 1u) : (jcur <= jlo + 1));
      const bool sel_only = (br == 1) && (jcur < cur);
      __builtin_amdgcn_sched_barrier(0);
      f32x4 s[2][4];
#pragma unroll
      for (int qt = 0; qt < 2; ++qt)
#pragma unroll
        for (int kt = 0; kt < 4; ++kt) s[qt][kt] = f32x4{0.f, 0.f, 0.f, 0.f};
#pragma unroll
      for (int kt = 0; kt < 4; ++kt)
#pragma unroll
        for (int ks = 0; ks < 4; ++ks) {
          if (ks == 0 && (kt & 1) == 0) __builtin_amdgcn_sched_barrier(0);
          bf16x8 a = *(const bf16x8*)(Ks + (kt * 16 + lq) * 136 + ks * 32 + g4 * 8);
          s[0][kt] = __builtin_amdgcn_mfma_f32_16x16x32_bf16(a, qf[0][ks], s[0][kt], 0, 0, 0);
          s[1][kt] = __builtin_amdgcn_mfma_f32_16x16x32_bf16(a, qf[1][ks], s[1][kt], 0, 0, 0);
        }
      bf16x8 pb[2][2];
#pragma unroll
      for (int qt = 0; qt < 2; ++qt) {
        __builtin_amdgcn_sched_barrier(0);
        const int t = t0 + qt * 16 + lq;
        const bool sel = (br == 2) || (((qt ? smq1 : smq0) >> jcur) & 1u);
        if (need_mask && sel_only) {
#pragma unroll
          for (int kt = 0; kt < 4; ++kt)
#pragma unroll
            for (int jj = 0; jj < 4; ++jj) s[qt][kt][jj] = sel ? s[qt][kt][jj] : NEG_INF;
        } else if (need_mask) {
#pragma unroll
          for (int kt = 0; kt < 4; ++kt)
#pragma unroll
            for (int jj = 0; jj < 4; ++jj) {
              int key = jcur * 64 + kt * 16 + g4 * 4 + jj;
              bool ok = sel && (key <= t) && (br == 1 || key > t - 512);
              s[qt][kt][jj] = ok ? s[qt][kt][jj] : NEG_INF;
            }
        }
        float sum = 0.f;
#pragma unroll
        for (int kt = 0; kt < 4; ++kt)
#pragma unroll
          for (int jj = 0; jj < 4; ++jj) { float pv = __builtin_amdgcn_exp2f(s[qt][kt][jj] - Mb); s[qt][kt][jj] = pv; sum += pv; }
        lrun[qt] += sum;
        pb[qt][0] = pack_p(s[qt][0], s[qt][1]);
        pb[qt][1] = pack_p(s[qt][2], s[qt][3]);
      }
      __builtin_amdgcn_sched_barrier(0);
#pragma unroll
      for (int m = 0; m < 2; ++m)
#pragma unroll
        for (int dt = 0; dt < 8; ++dt) {
          if (dt == 0 || dt == 4) __builtin_amdgcn_sched_barrier(0);
          const u16* vr = Vs + (dt * 16 + lq) * 72 + 32 * m + 4 * g4;
          bf16x8 a = ld2x64(vr, vr + 16);
          o[0][dt] = __builtin_amdgcn_mfma_f32_16x16x32_bf16(a, pb[0][m], o[0][dt], 0, 0, 0);
          o[1][dt] = __builtin_amdgcn_mfma_f32_16x16x32_bf16(a, pb[1][m], o[1][dt], 0, 0, 0);
        }
      j = jn;
    }
    __syncthreads();
    u16* stg = Ks + w * (32 * 136);
#pragma unroll
    for (int qt = 0; qt < 2; ++qt) {
      float l = lrun[qt];
      l += __shfl_xor(l, 16); l += __shfl_xor(l, 32);
      const float sc = (l > 0.f) ? gatef(qt, br) / l : 0.f;
#pragma unroll
      for (int dt = 0; dt < 8; ++dt) {
        u32x2 pk; pk[0] = pack2(o[qt][dt][0] * sc, o[qt][dt][1] * sc); pk[1] = pack2(o[qt][dt][2] * sc, o[qt][dt][3] * sc);
        *(u32x2*)(stg + (qt * 16 + lq) * 136 + dt * 16 + g4 * 4) = pk;
      }
    }
    {
      u16* ob = p.oattn3 + (size_t)br * T_ * 1024 + (size_t)(b * S_ + t0) * 1024 + hq * 128;
#pragma unroll 2
      for (int i = 0; i < 8; ++i) {
        const int idx = lane + i * 64, row = idx >> 4, c16 = idx & 15;
        const u32x4 v = *(const u32x4*)(stg + row * 136 + c16 * 8);
        *(u32x4*)(ob + (size_t)row * 1024 + c16 * 8) = v;
      }
    }
  }
}

DEV void ph_scan1(const Params& p, int item) {
  const int b = item / NCH, c = item % NCH, ch = ltid() * 4;
  const size_t base = (size_t)(b * S_ + c * CHL) * 1024 + ch;
  float A[4] = {1.f, 1.f, 1.f, 1.f}, H[4] = {0.f, 0.f, 0.f, 0.f};
#pragma unroll 8
  for (int t = 0; t < CHL; ++t) {
    float4 a = *(const float4*)(p.a_arr + base + (size_t)t * 1024);
    float4 bb = *(const float4*)(p.b_arr + base + (size_t)t * 1024);
    A[0] *= a.x; A[1] *= a.y; A[2] *= a.z; A[3] *= a.w;
    H[0] = a.x * H[0] + bb.x; H[1] = a.y * H[1] + bb.y; H[2] = a.z * H[2] + bb.z; H[3] = a.w * H[3] + bb.w;
  }
  *(float4*)(p.csA + (size_t)item * 1024 + ch) = make_float4(A[0], A[1], A[2], A[3]);
  *(float4*)(p.csH + (size_t)item * 1024 + ch) = make_float4(H[0], H[1], H[2], H[3]);
}
DEV void ph_scan2(const Params& p, int item) {
  const int b = item / NCH, c = item % NCH, ch = ltid() * 4;
  float H[4] = {0.f, 0.f, 0.f, 0.f};
  for (int c2 = 0; c2 < c; ++c2) {
    float4 a = *(const float4*)(p.csA + (size_t)(b * NCH + c2) * 1024 + ch);
    float4 hh = *(const float4*)(p.csH + (size_t)(b * NCH + c2) * 1024 + ch);
    H[0] = a.x * H[0] + hh.x; H[1] = a.y * H[1] + hh.y; H[2] = a.z * H[2] + hh.z; H[3] = a.w * H[3] + hh.w;
  }
  const size_t row0 = (size_t)(b * S_ + c * CHL);
#pragma unroll 8
  for (int t = 0; t < CHL; ++t) {
    float4 a = *(const float4*)(p.a_arr + (row0 + t) * 1024 + ch);
    float4 bb = *(const float4*)(p.b_arr + (row0 + t) * 1024 + ch);
    u32x2 xg = *(const u32x2*)(p.z + (row0 + t) * ZLD + CXG + ch);
    H[0] = a.x * H[0] + bb.x; H[1] = a.y * H[1] + bb.y; H[2] = a.z * H[2] + bb.z; H[3] = a.w * H[3] + bb.w;
    u32x2 pk;
    pk[0] = pack2(gelu_exact(bflo(xg[0])) * H[0], gelu_exact(bfhi(xg[0])) * H[1]);
    pk[1] = pack2(gelu_exact(bflo(xg[1])) * H[2], gelu_exact(bfhi(xg[1])) * H[3]);
    *(u32x2*)(p.orn + (row0 + t) * 1024 + ch) = pk;
  }
}

DEV void ph_ynorm_row(const Params& p, int row) {
  const int lane = ltid() & 63, c0 = lane * 16;
  float va[16], vr[16];
#pragma unroll
  for (int e = 0; e < 16; ++e) va[e] = 0.f;
#pragma unroll
  for (int br = 0; br < 3; ++br) {
    const u16* src = p.oattn3 + (size_t)br * T_ * 1024 + (size_t)row * 1024 + c0;
    u32x4 a = *(const u32x4*)src, b2 = *(const u32x4*)(src + 8);
#pragma unroll
    for (int e = 0; e < 4; ++e) { va[2 * e] += bflo(a[e]); va[2 * e + 1] += bfhi(a[e]); va[8 + 2 * e] += bflo(b2[e]); va[8 + 2 * e + 1] += bfhi(b2[e]); }
  }
  {
    const u16* src = p.orn + (size_t)row * 1024 + c0;
    u32x4 a = *(const u32x4*)src, b2 = *(const u32x4*)(src + 8);
#pragma unroll
    for (int e = 0; e < 4; ++e) { vr[2 * e] = bflo(a[e]); vr[2 * e + 1] = bfhi(a[e]); vr[8 + 2 * e] = bflo(b2[e]); vr[8 + 2 * e + 1] = bfhi(b2[e]); }
  }
  float sa = 0.f, sr = 0.f;
#pragma unroll
  for (int e = 0; e < 16; ++e) { sa += va[e] * va[e]; sr += vr[e] * vr[e]; }
  sa = wave_sum(sa); sr = wave_sum(sr);
  const float ra = rsqrtf(sa * (1.f / 1024.f) + 1e-6f), rr = rsqrtf(sr * (1.f / 1024.f) + 1e-6f);
  u32x4 o0, o1, o2, o3;
#pragma unroll
  for (int e = 0; e < 4; ++e) {
    o0[e] = pack2(va[2 * e] * ra * p.out_g_attn[c0 + 2 * e], va[2 * e + 1] * ra * p.out_g_attn[c0 + 2 * e + 1]);
    o1[e] = pack2(va[8 + 2 * e] * ra * p.out_g_attn[c0 + 8 + 2 * e], va[8 + 2 * e + 1] * ra * p.out_g_attn[c0 + 8 + 2 * e + 1]);
    o2[e] = pack2(vr[2 * e] * rr * p.out_g_rnn[c0 + 2 * e], vr[2 * e + 1] * rr * p.out_g_rnn[c0 + 2 * e + 1]);
    o3[e] = pack2(vr[8 + 2 * e] * rr * p.out_g_rnn[c0 + 8 + 2 * e], vr[8 + 2 * e + 1] * rr * p.out_g_rnn[c0 + 8 + 2 * e + 1]);
  }
  u16* dst = p.y + (size_t)row * 2048;
  *(u32x4*)(dst + c0) = o0; *(u32x4*)(dst + c0 + 8) = o1;
  *(u32x4*)(dst + 1024 + c0) = o2; *(u32x4*)(dst + 1024 + c0 + 8) = o3;
}

DEV void peer_route_item(const Params& p, int item, char* smem) {
  int tid_ = threadIdx.x;
  asm volatile("" : "+v"(tid_));
  const int tid = tid_, lane = tid & 63, w = tid >> 6, lq = lane & 15, g4 = lane >> 4;
  const int hh = item >> 8, tt = item & 255;
  const int tokL = w * 16 + lq, tok = tt * 64 + tokL;
  u16* Ks = (u16*)smem;
  float* topv = (float*)(smem + 34816);
  int* topi = (int*)(smem + 34816 + 8192);
  float* cvs = (float*)(smem + 34816 + 16384);
  int* candA = (int*)(smem + 34816 + 16384 + 13056);
  int* candB = candA + 50;
  const float NEG_INF = -__builtin_inff();
#pragma unroll 1
  for (int ph = 0; ph < 2; ++ph) {
    __syncthreads();
    {
      const u16* ksrc = p.keys_b + (size_t)(hh * 2 + ph) * 128 * 128;
      u32x4 kv[8];
#pragma unroll
      for (int i = 0; i < 8; ++i) { int id = tid + i * 256; kv[i] = *(const u32x4*)(ksrc + (size_t)(id >> 4) * 128 + (id & 15) * 8); }
#pragma unroll
      for (int i = 0; i < 8; ++i) { int id = tid + i * 256; *(u32x4*)(Ks + (id >> 4) * 136 + (id & 15) * 8) = kv[i]; }
      if (ph == 0 && tid < 50) {
        int c = tid, a = 0, off = 0;
        while (true) { int cnt = 16 / (a + 1); if (c < off + cnt) break; off += cnt; ++a; }
        candA[tid] = a; candB[tid] = c - off;
      }
    }
    __syncthreads();
    bf16x8 qf[4];
#pragma unroll
    for (int ks = 0; ks < 4; ++ks) qf[ks] = *(const bf16x8*)(p.pq + (size_t)tok * 2048 + hh * 256 + ph * 128 + ks * 32 + g4 * 8);
    f32x4 s[8];
#pragma unroll
    for (int kt = 0; kt < 8; ++kt) s[kt] = f32x4{0.f, 0.f, 0.f, 0.f};
#pragma unroll
    for (int kt = 0; kt < 8; ++kt)
#pragma unroll
      for (int ks = 0; ks < 4; ++ks) {
        bf16x8 a = *(const bf16x8*)(Ks + (kt * 16 + lq) * 136 + ks * 32 + g4 * 8);
        s[kt] = __builtin_amdgcn_mfma_f32_16x16x32_bf16(a, qf[ks], s[kt], 0, 0, 0);
      }
    unsigned r[32];
#pragma unroll
    for (int kt = 0; kt < 8; ++kt)
#pragma unroll
      for (int j = 0; j < 4; ++j) {
        const unsigned bits = __float_as_uint(s[kt][j]);
        const unsigned srt = bits ^ (((int)bits >> 31) | 0x80000000u);
        r[kt * 4 + j] = (srt & 0xFFFFFF80u) | (unsigned)(127 - (kt * 16 + g4 * 4 + j));
      }
#pragma unroll
    for (int k = 2; k <= 32; k <<= 1)
#pragma unroll
      for (int j = k >> 1; j > 0; j >>= 1)
#pragma unroll
        for (int i = 0; i < 32; ++i) {
          const int l = i ^ j;
          if (l > i) {
            const bool desc = ((i & k) == 0);
            const unsigned a = r[i], b2 = r[l];
            const unsigned hi = max(a, b2), lo = min(a, b2);
            r[i] = desc ? hi : lo; r[l] = desc ? lo : hi;
          }
        }
#pragma unroll 1
    for (int it = 0; it < 16; ++it) {
      unsigned mx = r[0];
      mx = max(mx, (unsigned)__shfl_xor((int)mx, 16)); mx = max(mx, (unsigned)__shfl_xor((int)mx, 32));
      const bool own = (r[0] == mx);
#pragma unroll
      for (int i = 0; i < 15; ++i) r[i] = own ? r[i + 1] : r[i];
      r[15] = own ? 0u : r[15];
      if (g4 == 0) {
        const unsigned srt = mx & 0xFFFFFF80u;
        const unsigned bits = srt ^ ((srt & 0x80000000u) ? 0x80000000u : 0xFFFFFFFFu);
        topv[(tokL * 2 + ph) * 16 + it] = __uint_as_float(bits);
        topi[(tokL * 2 + ph) * 16 + it] = 127 - (int)(mx & 127u);
      }
    }
  }
  __syncthreads();
  const int tl = tid >> 2, sub = tid & 3;
  unsigned* cvu = (unsigned*)cvs;
  unsigned mine[13];
#pragma unroll
  for (int i = 0; i < 13; ++i) {
    const int c = sub + 4 * i;
    mine[i] = 0xFFFFFFFFu;
    if (c < 50) {
      const float v = topv[(tl * 2 + 0) * 16 + candA[c]] + topv[(tl * 2 + 1) * 16 + candB[c]];
      const unsigned bits = __float_as_uint(v);
      const unsigned srt = bits ^ (((int)bits >> 31) | 0x80000000u);
      const unsigned pk = (srt & 0xFFFFFFC0u) | (unsigned)(63 - c);
      cvu[tl * 51 + c] = pk; mine[i] = pk;
    }
  }
  __syncthreads();
  {
    int rank[13];
#pragma unroll
    for (int i = 0; i < 13; ++i) rank[i] = 0;
#pragma unroll 5
    for (int c2 = 0; c2 < 50; ++c2) {
      const unsigned o = cvu[tl * 51 + c2];
#pragma unroll
      for (int i = 0; i < 13; ++i) rank[i] += (o > mine[i]) ? 1 : 0;
    }
    auto unpk = [](unsigned pk) -> float {
      const unsigned srt = pk & 0xFFFFFFC0u;
      return __uint_as_float(srt ^ ((srt & 0x80000000u) ? 0x80000000u : 0xFFFFFFFFu));
    };
    const float vmax = unpk(cvu[tl * 51]);
    float wpart = 0.f;
    float ev[13];
#pragma unroll
    for (int i = 0; i < 13; ++i) {
      ev[i] = 0.f;
      if (sub + 4 * i < 50 && rank[i] < 16) { ev[i] = __expf(unpk(mine[i]) - vmax); wpart += ev[i]; }
    }
    float wsum = wpart + __shfl_xor(wpart, 1);
    wsum += __shfl_xor(wsum, 2);
    const float winv = 1.f / wsum;
    const size_t ob = (size_t)(tt * 64 + tl) * 128 + hh * 16;
#pragma unroll
    for (int i = 0; i < 13; ++i) {
      const int c = sub + 4 * i;
      if (c < 50 && rank[i] < 16) {
        p.eidx[ob + rank[i]] = topi[(tl * 2 + 0) * 16 + candA[c]] * 128 + topi[(tl * 2 + 1) * 16 + candB[c]];
        p.gw[ob + rank[i]] = ev[i] * winv;
      }
    }
  }
}

DEV float dpp_row_sum(float v) {
  v += __builtin_bit_cast(float, __builtin_amdgcn_update_dpp(0, __builtin_bit_cast(int, v), 0xB1, 0xF, 0xF, true));
  v += __builtin_bit_cast(float, __builtin_amdgcn_update_dpp(0, __builtin_bit_cast(int, v), 0x4E, 0xF, 0xF, true));
  v += __builtin_bit_cast(float, __builtin_amdgcn_update_dpp(0, __builtin_bit_cast(int, v), 0x141, 0xF, 0xF, true));
  v += __builtin_bit_cast(float, __builtin_amdgcn_update_dpp(0, __builtin_bit_cast(int, v), 0x140, 0xF, 0xF, true));
  return v;
}
DEV float wave_sum_fast(float v) {
  v = dpp_row_sum(v);
  int iv = __builtin_bit_cast(int, v);
  float s0 = __builtin_bit_cast(float, __builtin_amdgcn_readlane(iv, 0));
  float s1 = __builtin_bit_cast(float, __builtin_amdgcn_readlane(iv, 16));
  float s2 = __builtin_bit_cast(float, __builtin_amdgcn_readlane(iv, 32));
  float s3 = __builtin_bit_cast(float, __builtin_amdgcn_readlane(iv, 48));
  return (s0 + s1) + (s2 + s3);
}
constexpr float DOWN_SCALE = 64.f, UP_SCALE = 4.f;

typedef float v32f __attribute__((ext_vector_type(32)));
typedef float v16f __attribute__((ext_vector_type(16)));
typedef unsigned v6u __attribute__((ext_vector_type(6)));
constexpr int ROW6 = 1536;

DEV void peer_gather_token(const Params& p, int tok) {
  const int lane = ltid() & 63, b = tok >> 11;
  float hx[32], acc[32];
  {
    const u16* hr = p.h + (size_t)tok * 2048 + lane * 32;
#pragma unroll
    for (int q = 0; q < 4; ++q) {
      u32x4 v = *(const u32x4*)(hr + q * 8);
#pragma unroll
      for (int e = 0; e < 4; ++e) { hx[q * 8 + 2 * e] = bflo(v[e]); hx[q * 8 + 2 * e + 1] = bfhi(v[e]); }
    }
  }
#pragma unroll
  for (int e = 0; e < 32; ++e) acc[e] = 0.f;
  const int e0 = p.eidx[(size_t)tok * 128 + lane], e1 = p.eidx[(size_t)tok * 128 + 64 + lane];
  const int g0 = __builtin_bit_cast(int, p.gw[(size_t)tok * 128 + lane]), g1 = __builtin_bit_cast(int, p.gw[(size_t)tok * 128 + 64 + lane]);
  u32x2 dn[4][3], up[4][3];
  auto issue = [&](int k, int slot) {
    const int e = (k < 64) ? __builtin_amdgcn_readlane(e0, k) : __builtin_amdgcn_readlane(e1, k - 64);
    const unsigned char* dr = p.down8 + (size_t)e * ROW6 + lane * 24;
    const unsigned char* ur = p.up8 + (size_t)e * ROW6 + lane * 24;
#pragma unroll
    for (int i = 0; i < 3; ++i) { dn[slot][i] = *(const u32x2*)(dr + i * 8); up[slot][i] = *(const u32x2*)(ur + i * 8); }
  };
  issue(0, 0); issue(1, 1); issue(2, 2);
#pragma unroll 1
  for (int k4 = 0; k4 < 128; k4 += 4) {
#pragma unroll
    for (int s = 0; s < 4; ++s) {
      const int k = k4 + s;
      if (k + 3 < 128) issue(k + 3, (s + 3) & 3);
      const v6u dq = v6u{dn[s][0][0], dn[s][0][1], dn[s][1][0], dn[s][1][1], dn[s][2][0], dn[s][2][1]};
      const v32f dv = __builtin_amdgcn_cvt_scalef32_pk32_f32_fp6(dq, 1.0f);
      float d0 = 0.f, d1 = 0.f, d2 = 0.f, d3 = 0.f;
#pragma unroll
      for (int i = 0; i < 8; ++i) { d0 += dv[4 * i] * hx[4 * i]; d1 += dv[4 * i + 1] * hx[4 * i + 1]; d2 += dv[4 * i + 2] * hx[4 * i + 2]; d3 += dv[4 * i + 3] * hx[4 * i + 3]; }
      const float d = wave_sum_fast((d0 + d1) + (d2 + d3)) * (1.f / DOWN_SCALE);
      const float gk = __builtin_bit_cast(float, (k < 64) ? __builtin_amdgcn_readlane(g0, k) : __builtin_amdgcn_readlane(g1, k - 64));
      const float act = gelu_exact(d) * gk * (1.f / UP_SCALE);
      const v6u uq = v6u{up[s][0][0], up[s][0][1], up[s][1][0], up[s][1][1], up[s][2][0], up[s][2][1]};
      const v32f uv = __builtin_amdgcn_cvt_scalef32_pk32_f32_fp6(uq, 1.0f);
#pragma unroll
      for (int i = 0; i < 32; ++i) acc[i] += act * uv[i];
    }
  }
  const float* gt2 = p.mod + (size_t)b * 12288 + 10240;
  float* orow = p.out + (size_t)tok * 2048;
#pragma unroll
  for (int q = 0; q < 8; ++q) {
    const int col = lane * 32 + q * 4;
    float4 x0 = *(const float4*)(orow + col);
    float4 ga = *(const float4*)(gt2 + col);
    x0.x += ga.x * acc[q * 4 + 0]; x0.y += ga.y * acc[q * 4 + 1]; x0.z += ga.z * acc[q * 4 + 2]; x0.w += ga.w * acc[q * 4 + 3];
    *(float4*)(orow + col) = x0;
  }
}

#define XB_TMO      128
#define XB_XCNT(j)  (256  + 64 * (j))
#define XB_XSUB(j)  (1280 + 64 * (j))
#define XB_XGEN(j)  (2304 + 64 * (j))
#define XB_TOP      3328
#define XB_TOPGEN   3392
#define XCD_BAR_WORDS 3456
#define XB_SPIN_CAP (1u << 20)
DEV unsigned xb_ld(unsigned* p) { return __hip_atomic_load(p, __ATOMIC_RELAXED, __HIP_MEMORY_SCOPE_AGENT); }
DEV unsigned xb_add(unsigned* p, unsigned v) { return __hip_atomic_fetch_add(p, v, __ATOMIC_RELAXED, __HIP_MEMORY_SCOPE_AGENT); }
DEV unsigned xb_xcc_id() { return (unsigned)__builtin_amdgcn_s_getreg((3 << 11) | 20) & 0xFu; }
#define XB_SPIN(cond, bar) do { unsigned _sp = 0; while (cond) { __builtin_amdgcn_s_sleep(1); \
    if ((++_sp & 255u) == 0u) { if (xb_ld(&(bar)[XB_TMO])) break; if (_sp > XB_SPIN_CAP) { atomicAdd(&(bar)[XB_TMO], 1u); break; } } } } while (0)

DEV void xcd_barrier_complete(unsigned* bar, unsigned x, unsigned& nloc, unsigned& nx) {
  const unsigned G = gridDim.x;
  unsigned sum, cnt, mine, sp = 0u;
  for (;;) {
    sum = 0u; cnt = 0u; mine = 0u;
#pragma unroll
    for (unsigned j = 0; j < 16; ++j) { const unsigned c = xb_ld(&bar[XB_XCNT(j)]); sum += c; cnt += (c > 0u) ? 1u : 0u; mine = (j == x) ? c : mine; }
    if (sum == G) break;
    __builtin_amdgcn_s_sleep(1);
    if ((++sp & 255u) == 0u) { if (xb_ld(&bar[XB_TMO])) break; if (sp > XB_SPIN_CAP) { atomicAdd(&bar[XB_TMO], 1u); break; } }
  }
  nloc = mine > 0u ? mine : 1u; nx = cnt > 0u ? cnt : 1u;
}
DEV void xcd_barrier(unsigned* bar, unsigned x, volatile unsigned* st) {
  asm volatile("s_waitcnt vmcnt(0)" ::: "memory");
  __syncthreads();
  if (threadIdx.x == 0) {
    __builtin_amdgcn_s_waitcnt(0);
    unsigned nloc = st[0], nx = st[1];
    if (nloc == 0u) { xcd_barrier_complete(bar, x, nloc, nx); st[0] = nloc; st[1] = nx; }
    const unsigned old = xb_add(&bar[XB_XSUB(x)], 1u);
    const unsigned gen = old / nloc;
    if (old + 1u == (gen + 1u) * nloc) {
      __builtin_amdgcn_fence(__ATOMIC_RELEASE, "agent");
      asm volatile("s_waitcnt vmcnt(0)" ::: "memory");
      const unsigned og = xb_add(&bar[XB_TOP], 1u);
      const unsigned tg = og / nx;
      if (og + 1u == (tg + 1u) * nx) xb_add(&bar[XB_TOPGEN], 1u);
      else XB_SPIN(xb_ld(&bar[XB_TOPGEN]) == tg, bar);
      __builtin_amdgcn_fence(__ATOMIC_ACQUIRE, "agent");
      xb_add(&bar[XB_XGEN(x)], 1u);
      asm volatile("s_waitcnt vmcnt(0)" ::: "memory");
    } else {
      XB_SPIN(xb_ld(&bar[XB_XGEN(x)]) == gen, bar);
      __builtin_amdgcn_fence(__ATOMIC_ACQUIRE, "agent");
      asm volatile("s_waitcnt vmcnt(0)" ::: "memory");
    }
  }
  __syncthreads();
}

__global__ void __launch_bounds__(256, 2) fwd_megakernel(Params p) {
  __shared__ __attribute__((aligned(16))) char smem[SMEM_BYTES];
  const int nb = gridDim.x, bid = blockIdx.x;
  __shared__ uint4 xb_words;
  if (threadIdx.x == 0) xb_words = make_uint4(0u, 0u, 0u, 0u);
  __syncthreads();
  const unsigned xcc = xb_xcc_id();
  if (threadIdx.x == 0) (void)xb_add(&p.bar[XB_XCNT(xcc)], 1u);
  volatile unsigned* xb_st = (volatile unsigned*)&xb_words;
  float* smf = (float*)smem;
#define FRESH_TID() int tid = threadIdx.x; asm volatile("" : "+v"(tid)); const int wid = tid >> 6; (void)wid;

  {
    FRESH_TID();
  {
    const int n_mod = 384, n_tin = 32 * 74, n_tout = 1024, n_tq = 1024, n_tck = 128, n_tcv = 128, n_cb = 2, n_g = 128, n_rt = 512, n_kb = 128;
    const int total = n_mod + n_tin + n_tout + n_tq + n_tck + n_tcv + n_cb + n_g + n_rt + n_kb;
    for (int it = bid; it < total; it += nb) {
      int i = it;
      if (i < n_mod) { ph_modpart(p, i, smf); continue; }
      i -= n_mod;
      if (i < n_tin) { ph_transpose(p.w_in, 2048, NIN, ZLD, p.Wt_in, i, smf); continue; }
      i -= n_tin;
      if (i < n_tout) { ph_transpose(p.w_out, 2048, 2048, 2048, p.Wt_out, i, smf); continue; }
      i -= n_tout;
      if (i < n_tq) { ph_transpose(p.peer_wq, 2048, 2048, 2048, p.Wt_q, i, smf); continue; }
      i -= n_tq;
      if (i < n_tck) { ph_transpose(p.cmp_w_k, 4096, 128, 128, p.Wt_ck, i, smf); continue; }
      i -= n_tck;
      if (i < n_tcv) { ph_transpose(p.cmp_w_v, 4096, 128, 128, p.Wt_cv, i, smf); continue; }
      i -= n_tcv;
      if (i < n_cb) { for (int e = tid; e < 4096; e += 256) p.pe_b[i * 4096 + e] = f2bf((i ? p.cmp_pe_v : p.cmp_pe_k)[e]); continue; }
      i -= n_cb;
      if (i >= n_g + n_rt) {
        const int e0 = (i - n_g - n_rt) * 2048 + tid * 8;
        float4 a0 = *(const float4*)(p.peer_keys + e0), a1 = *(const float4*)(p.peer_keys + e0 + 4);
        u32x4 o; o[0] = pack2(a0.x, a0.y); o[1] = pack2(a0.z, a0.w); o[2] = pack2(a1.x, a1.y); o[3] = pack2(a1.z, a1.w);
        *(u32x4*)(p.keys_b + e0) = o;
        continue;
      }
      if (i >= n_g) {
        const int e = (i - n_g) * 256 + tid, pos = e >> 6, d = e & 63;
        const float freq = exp2f(-(float)d * (13.287712379549449f / 64.f));
        float sn, cs;
        sincosf((float)pos * freq, &sn, &cs);
        p.rope_tab[(size_t)e * 2] = cs; p.rope_tab[(size_t)e * 2 + 1] = sn;
        continue;
      }
      {
        for (int e = i * 2048 + tid; e < (i + 1) * 2048; e += 256) {
          int d = e & 127, jr = (e >> 7) & 255, n = e >> 15;
          int hf = jr >> 7, j = jr & 127, wc = j >> 6, nn = (j >> 4) & 3, fr = j & 15;
          int chl = hf * 64 + wc * 32 + (nn & 1) * 16 + fr;
          const float* src = (nn >> 1) ? p.lru_wi : p.lru_wa;
          p.Wt_g[e] = f2bf(src[((size_t)n * 128 + d) * 128 + chl]);
        }
      }
    }
  }
  }
  xcd_barrier(p.bar, xcc, xb_st);
  {
    FRESH_TID();
  for (int e = bid * 256 + tid; e < 8 * 12288; e += nb * 256) {
    int b = e / 12288, n = e % 12288;
    float s = p.ada_b[n];
    for (int kc = 0; kc < 32; ++kc) s += p.modpart[((size_t)(kc * 8 + b)) * 12288 + n];
    p.mod[e] = s;
  }
  }
  xcd_barrier(p.bar, xcc, xb_st);
  {
    FRESH_TID();
  for (int row = bid * 4 + wid; row < T_; row += nb * 4) ph_adaln_row(p.x, p.norm_mix_g, p.mod, 0, 2048, p.h, row);
  }
  xcd_barrier(p.bar, xcc, xb_st);
  {
    FRESH_TID();
  for (int jt = (bid >> 3); jt < 8 * 37; jt += (nb >> 3)) {
    const int pn = jt >> 3, pm = (bid & 7) * 8 + (jt & 7);
    const u16* A = p.h + (size_t)pm * 256 * 2048;
    gemm_tile256([&](int r, int k) { return A + (size_t)r * 2048 + k; }, p.Wt_in + (size_t)pn * 128 * 2048, 2048, 2048,
              [&](auto&& stager, int h) {
                const int pme = pm * 2 + h;
                stager(smf, 129);
                const int t2 = ltid(), r = t2 >> 1, hf = t2 & 1;
                const int tok = pme * 128 + r;
                float* gcol = smf + 128 * 129;
                int kind = 0; const float* gn = nullptr; float osc = 1.f; u16* vT = nullptr;
                if (pn < 8) { kind = 1; gn = p.q_norm_g; osc = QSCALE; }
                else if (pn < 10) { kind = 2; }
                else if (pn < 12) { kind = 0; }
                else if (pn < 14) { kind = 1; gn = p.k_norm_g + 128; }
                else if (pn < 16) { kind = 3; vT = p.vsT + (size_t)(((pme >> 4) * 2 + (pn - 14)) * 128) * S_; }
                else if (pn < 18) { kind = 1; gn = p.k_norm_g + 256; }
                else if (pn < 20) { kind = 3; vT = p.vwT + (size_t)(((pme >> 4) * 2 + (pn - 18)) * 128) * S_; }
                if (t2 < 128) gcol[t2] = (kind == 1) ? gn[t2] : 1.f;
                __syncthreads();
                if (kind == 0) {
                  store_row_bf16(smf + r * 129 + hf * 64, p.z + (size_t)tok * ZLD + pn * 128 + hf * 64);
                } else if (kind == 3) {
                  const int t0 = (pme & 15) * 128 + hf * 64;
                  u16* dst = vT + (size_t)r * S_ + t0;
#pragma unroll
                  for (int q = 0; q < 8; ++q) {
                    u32x4 o;
#pragma unroll
                    for (int e = 0; e < 4; ++e) o[e] = pack2(smf[(hf * 64 + q * 8 + 2 * e) * 129 + r], smf[(hf * 64 + q * 8 + 2 * e + 1) * 129 + r]);
                    *(u32x4*)(dst + q * 8) = o;
                  }
                } else {
                  const int lane2 = t2 & 63, w2 = t2 >> 6;
                  const float g1 = gcol[lane2], g2 = gcol[64 + lane2];
                  const float* tabw = p.rope_tab + ((size_t)((pme * 128 + w2 * 32) & 2047) * 64 + lane2) * 2;
                  u16* dstw = p.z + (size_t)(pme * 128 + w2 * 32) * ZLD + pn * 128 + lane2;
#pragma unroll 1
                  for (int r8 = 0; r8 < 32; r8 += 8) {
                  float2 csr[8];
#pragma unroll
                  for (int rr = 0; rr < 8; ++rr) csr[rr] = *(const float2*)(tabw + (size_t)(r8 + rr) * 128);
#pragma unroll
                  for (int r1 = 0; r1 < 8; ++r1) {
                    const int rr = r8 + r1;
                    const float* sr2 = smf + (w2 * 32 + rr) * 129;
                    float x1 = sr2[lane2], x2 = sr2[64 + lane2];
                    const float2 cs2 = csr[r1];
                    float sc = osc;
                    if (kind == 1) {
                      const float ss = wave_sum_fast(x1 * x1 + x2 * x2);
                      sc = rsqrtf(ss * (1.f / 128.f) + 1e-6f) * osc;
                    }
                    x1 *= sc * g1; x2 *= sc * g2;
                    dstw[(size_t)rr * ZLD] = f2bf(x1 * cs2.x - x2 * cs2.y);
                    dstw[(size_t)rr * ZLD + 64] = f2bf(x2 * cs2.x + x1 * cs2.y);
                  }
                  }
                }
                __syncthreads();
              }, smem);
  }
  }
  xcd_barrier(p.bar, xcc, xb_st);
  {
    FRESH_TID();
  for (int t8 = bid * 4 + wid; t8 < T_ / 8; t8 += nb * 4) ph_conv_tokens(p, t8 * 8);
  for (int it = nb - 1 - bid; it < 128; it += nb) {
        const int ks = it & 3, tile = it >> 2, which = tile >> 4, bg = tile & 15, b = bg >> 1, g = bg & 1;
        const u16* zbase = p.z + (size_t)(b * S_) * ZLD + (which ? CVC : CKC) + g * 128;
        const u16* peb = p.pe_b + which * 4096 + ks * 1024;
        float* cp = p.cpart + (size_t)it * 128 * 128;
        gemm_tile([&](int r, int k) { return r < 127 ? zbase + (size_t)(16 * r + ks * 8 + (k >> 7)) * ZLD + (k & 127) : peb + k; },
                  (which ? p.Wt_cv : p.Wt_ck) + ks * 1024, 4096, 1024,
                  [&](f32x4 (&acc)[4][4], int wr, int wc, int fr, int fq) {
#pragma unroll
                    for (int m = 0; m < 4; ++m)
#pragma unroll
                      for (int n = 0; n < 4; ++n)
#pragma unroll
                        for (int j = 0; j < 4; ++j) cp[(wr * 64 + m * 16 + fq * 4 + j) * 128 + wc * 64 + n * 16 + fr] = acc[m][n][j];
                  }, smem);
  }
  }
  xcd_barrier(p.bar, xcc, xb_st);
  {
    FRESH_TID();
  {
  for (int tile = bid; tile < 32; tile += nb) {
    const int which = tile >> 4, bg = tile & 15;
    const float* cp = p.cpart + (size_t)tile * 4 * 128 * 128;
    __syncthreads();
    for (int e = tid; e < 128 * 32; e += 256) {
      const int r = e >> 5, c4 = e & 31;
      float4 v = *(const float4*)(cp + (size_t)r * 128 + c4 * 4);
#pragma unroll
      for (int ks = 1; ks < 4; ++ks) {
        float4 w = *(const float4*)(cp + (size_t)ks * 16384 + (size_t)r * 128 + c4 * 4);
        v.x += w.x; v.y += w.y; v.z += w.z; v.w += w.w;
      }
      smf[r * 129 + c4 * 4] = v.x; smf[r * 129 + c4 * 4 + 1] = v.y; smf[r * 129 + c4 * 4 + 2] = v.z; smf[r * 129 + c4 * 4 + 3] = v.w;
    }
    __syncthreads();
    const int rr = tid & 127, hf = tid >> 7;
    if (!which) {
      float ss = 0.f;
      for (int c = 0; c < 128; ++c) { float v = smf[rr * 129 + c] + smf[127 * 129 + c]; ss += v * v; }
      float rs = rsqrtf(ss * (1.f / 128.f) + 1e-6f);
      if (rr == 127) rs = 0.f;
      for (int c = hf * 64; c < hf * 64 + 64; ++c) p.kcmp[((size_t)bg * 128 + rr) * 128 + c] = f2bf((smf[rr * 129 + c] + smf[127 * 129 + c]) * rs * p.k_norm_g[c]);
    } else {
      for (int r = hf * 64; r < hf * 64 + 64; ++r) p.vcT[((size_t)bg * 128 + rr) * 128 + r] = (r == 127) ? (u16)0 : f2bf(smf[r * 129 + rr] + smf[127 * 129 + rr]);
    }
  }
    const int n_c = 0, n_gate = 2048;
    for (int it = bid; it < n_c + n_gate; it += nb) {
      {
        const int i = it - n_c, hf = i & 1, n = (i >> 1) & 7, mt = i >> 4;
        const u16* A = p.U + (size_t)mt * 128 * 1024 + n * 128;
        gemm_tile([&](int r, int k) { return A + (size_t)r * 1024 + k; }, p.Wt_g + (size_t)((n * 2 + hf) * 128) * 128, 128, 128,
                  [&](f32x4 (&acc)[4][4], int wr, int wc, int fr, int fq) {
                    float uv[2][4][4];
                    {
                      const u16* ring = (const u16*)(smem + (hf * 2 + wc) * 16384);
#pragma unroll
                      for (int nn = 0; nn < 2; ++nn)
#pragma unroll
                        for (int m = 0; m < 4; ++m)
#pragma unroll
                          for (int j = 0; j < 4; ++j) uv[nn][m][j] = bf2f(ring[(wr * 64 + m * 16 + fq * 4 + j) * 32 + nn * 16 + fr]);
                    }
                    __syncthreads();
#pragma unroll
                    for (int nn = 0; nn < 2; ++nn) {
                      const int ch = n * 128 + hf * 64 + wc * 32 + nn * 16 + fr;
                      const float ba = p.lru_ba[ch], bi = p.lru_bi[ch], lam = p.lru_lam[ch];
                      const float sp = log1pf(__expf(-lam));
#pragma unroll
                      for (int m = 0; m < 4; ++m)
#pragma unroll
                        for (int j = 0; j < 4; ++j) {
                          float r = sigmoidf_(acc[m][nn][j] + ba), ig = sigmoidf_(acc[m][nn + 2][j] + bi);
                          float la = -8.f * r * sp;
                          float a = __expf(la);
                          float u = uv[nn][m][j];
                          float bb = sqrtf(fmaxf(-expm1f(2.f * la), 0.f)) * ig * u;
                          const int rl = wr * 64 + m * 16 + fq * 4 + j, cl = wc * 32 + nn * 16 + fr;
                          smf[rl * 68 + cl] = a; smf[8704 + rl * 68 + cl] = bb;
                        }
                    }
                    __syncthreads();
                    {
                      const int t3 = ltid(), c4 = t3 & 15, r0 = t3 >> 4;
                      const size_t gbase = ((size_t)mt * 128) * 1024 + n * 128 + hf * 64 + c4 * 4;
#pragma unroll 4
                      for (int ps = 0; ps < 8; ++ps) {
                        const int r = ps * 16 + r0;
                        *(float4*)(p.a_arr + gbase + (size_t)r * 1024) = *(const float4*)(smf + r * 68 + c4 * 4);
                        *(float4*)(p.b_arr + gbase + (size_t)r * 1024) = *(const float4*)(smf + 8704 + r * 68 + c4 * 4);
                      }
                    }
                    __syncthreads();
                  }, smem);
      }
    }
  }
  }
  xcd_barrier(p.bar, xcc, xb_st);
  {
    FRESH_TID();
  {
    const int n_attn = 1024, n_s1 = B_ * NCH;
    if (nb == 512) {
      const int x = bid & 7, l = bid >> 3, bg = 2 * x + (l & 1), k = l >> 1;
      attn_item(p, (k << 4) | bg, smem);
      attn_item(p, ((63 - k) << 4) | bg, smem);
      ph_scan1(p, bid);
    } else {
      for (int it = bid; it < n_attn + n_s1; it += nb) {
        if (it < n_attn) attn_item(p, it, smem);
        else ph_scan1(p, it - n_attn);
      }
    }
  }
  }
  xcd_barrier(p.bar, xcc, xb_st);
  {
    FRESH_TID();
  for (int it = bid; it < B_ * NCH; it += nb) ph_scan2(p, it);
  }
  xcd_barrier(p.bar, xcc, xb_st);
  {
    FRESH_TID();
  for (int row = bid * 4 + wid; row < T_; row += nb * 4) ph_ynorm_row(p, row);
  for (size_t blk = (size_t)bid * 256 + tid; blk < (size_t)16384 * 64; blk += (size_t)nb * 256) {
#pragma unroll
    for (int tb = 0; tb < 2; ++tb) {
      const float* src = (tb ? p.peer_up : p.peer_down) + blk * 32;
      const float sc = tb ? UP_SCALE : DOWN_SCALE;
      v16f va, vb;
#pragma unroll
      for (int q = 0; q < 4; ++q) {
        const float4 x = *(const float4*)(src + q * 8), y = *(const float4*)(src + q * 8 + 4);
        va[q * 4] = x.x * sc; vb[q * 4] = x.y * sc; va[q * 4 + 1] = x.z * sc; vb[q * 4 + 1] = x.w * sc;
        va[q * 4 + 2] = y.x * sc; vb[q * 4 + 2] = y.y * sc; va[q * 4 + 3] = y.z * sc; vb[q * 4 + 3] = y.w * sc;
      }
      const v6u o = __builtin_amdgcn_cvt_scalef32_2xpk16_fp6_f32(va, vb, 1.0f);
      unsigned char* dst = (tb ? p.up8 : p.down8) + blk * 24;
      *(u32x2*)dst = u32x2{o[0], o[1]}; *(u32x2*)(dst + 8) = u32x2{o[2], o[3]}; *(u32x2*)(dst + 16) = u32x2{o[4], o[5]};
    }
  }
  }
  xcd_barrier(p.bar, xcc, xb_st);
  {
    FRESH_TID();
  for (int jt = (bid >> 3); jt < 8 * 16; jt += (nb >> 3)) {
    const int pn = jt >> 3, pm = (bid & 7) * 8 + (jt & 7), b = pm >> 3;
    const u16* A = p.y + (size_t)pm * 256 * 2048;
    const float* gt1 = p.mod + (size_t)b * 12288 + 4096 + pn * 128;
    gemm_tile256([&](int r, int k) { return A + (size_t)r * 2048 + k; }, p.Wt_out + (size_t)pn * 128 * 2048, 2048, 2048,
              [&](auto&& stager, int h) {
                const float* xin = p.x + (size_t)(pm * 2 + h) * 128 * 2048 + pn * 128;
                float* ot = p.out + (size_t)(pm * 2 + h) * 128 * 2048 + pn * 128;
                stager(smf, 132);
                __syncthreads();
                const int t2 = ltid(), c4 = t2 & 31, r0 = t2 >> 5;
                const float4 g = *(const float4*)(gt1 + c4 * 4);
#pragma unroll 4
                for (int ps = 0; ps < 16; ++ps) {
                  const int r = ps * 8 + r0;
                  const float4 sv = *(const float4*)(smf + r * 132 + c4 * 4);
                  float4 xv = *(const float4*)(xin + (size_t)r * 2048 + c4 * 4);
                  xv.x += g.x * sv.x; xv.y += g.y * sv.y; xv.z += g.z * sv.z; xv.w += g.w * sv.w;
                  *(float4*)(ot + (size_t)r * 2048 + c4 * 4) = xv;
                }
                __syncthreads();
              }, smem);
  }
  }
  xcd_barrier(p.bar, xcc, xb_st);
  {
    FRESH_TID();
  for (int row = bid * 4 + wid; row < T_; row += nb * 4) ph_adaln_row(p.out, p.norm_ffn_g, p.mod, 6144, 8192, p.h, row);
  }
  xcd_barrier(p.bar, xcc, xb_st);
  {
    FRESH_TID();
  for (int jt = (bid >> 3); jt < 8 * 16; jt += (nb >> 3)) {
    const int pn = jt >> 3, pm = (bid & 7) * 8 + (jt & 7);
    const u16* A = p.h + (size_t)pm * 256 * 2048;
    gemm_tile256([&](int r, int k) { return A + (size_t)r * 2048 + k; }, p.Wt_q + (size_t)pn * 128 * 2048, 2048, 2048,
              [&](auto&& stager, int h) {
                u16* ot = p.pq + (size_t)(pm * 2 + h) * 128 * 2048 + pn * 128;
                stager(smf, 132);
                __syncthreads();
                const int t2 = ltid(), c8 = t2 & 15, r0 = t2 >> 4;
#pragma unroll 4
                for (int ps = 0; ps < 8; ++ps) {
                  const int r = ps * 16 + r0;
                  const float4 s0 = *(const float4*)(smf + r * 132 + c8 * 8), s1 = *(const float4*)(smf + r * 132 + c8 * 8 + 4);
                  u32x4 o; o[0] = pack2(s0.x, s0.y); o[1] = pack2(s0.z, s0.w); o[2] = pack2(s1.x, s1.y); o[3] = pack2(s1.z, s1.w);
                  *(u32x4*)(ot + (size_t)r * 2048 + c8 * 8) = o;
                }
                __syncthreads();
              }, smem);
  }
  }
  xcd_barrier(p.bar, xcc, xb_st);
  {
    FRESH_TID();
  for (int it = bid; it < 8 * 256; it += nb) peer_route_item(p, it, smem);
  }
  xcd_barrier(p.bar, xcc, xb_st);
  {
    FRESH_TID();
  for (int tok = bid * 4 + wid; tok < T_; tok += nb * 4) peer_gather_token(p, tok);
  }
}

extern "C" void kernel_launch(void* const* d_in, const int* in_sizes, int n_in, void* d_out, int out_size, void* d_ws, size_t ws_size,
                              hipStream_t stream) {
  static int grid_blocks = 0;
  if (!grid_blocks) {
    int dev = 0, cus = 0, per_cu = 0;
    (void)hipGetDevice(&dev);
    (void)hipDeviceGetAttribute(&cus, hipDeviceAttributeMultiprocessorCount, dev);
    (void)hipOccupancyMaxActiveBlocksPerMultiprocessor(&per_cu, fwd_megakernel, 256, 0);
    if (per_cu > 2) per_cu = 2;
    if (per_cu < 1) per_cu = 1;
    grid_blocks = cus * per_cu;
  }
  Params p{};
  const float* const* in = (const float* const*)d_in;
  p.x = in[0]; p.c = in[1]; p.ada_w = in[2]; p.ada_b = in[3]; p.norm_mix_g = in[4]; p.norm_ffn_g = in[5]; p.w_in = in[6]; p.w_out = in[7];
  p.q_norm_g = in[8]; p.k_norm_g = in[9]; p.cmp_pe_k = in[10]; p.cmp_pe_v = in[11]; p.cmp_w_k = in[12]; p.cmp_w_v = in[13]; p.gate_b = in[14];
  p.conv_w = in[15]; p.conv_b = in[16]; p.lru_wa = in[17]; p.lru_ba = in[18]; p.lru_wi = in[19]; p.lru_bi = in[20]; p.lru_lam = in[21];
  p.out_g_attn = in[22]; p.out_g_rnn = in[23]; p.peer_wq = in[24]; p.peer_keys = in[25]; p.peer_down = in[26]; p.peer_up = in[27];
  p.out = (float*)d_out;
  char* ws = (char*)d_ws;
  size_t off = 0;
  auto take = [&](size_t bytes) { char* r = ws + off; off += (bytes + 255) & ~(size_t)255; return r; };
  p.Wt_in = (u16*)take((size_t)ZLD * 2048 * 2);
  p.Wt_out = (u16*)take((size_t)2048 * 2048 * 2);
  p.Wt_q = (u16*)take((size_t)2048 * 2048 * 2);
  p.Wt_ck = (u16*)take((size_t)128 * 4096 * 2);
  p.Wt_cv = (u16*)take((size_t)128 * 4096 * 2);
  p.Wt_g = (u16*)take((size_t)8 * 256 * 128 * 2);
  p.cbias = (float*)take(256 * 4);
  p.modpart = (float*)take((size_t)32 * 8 * 12288 * 4);
  p.mod = (float*)take((size_t)8 * 12288 * 4);
  p.h = (u16*)take((size_t)T_ * 2048 * 2);
  (void)take((size_t)T_ * 1024 * 2);
  p.oattn3 = p.h;
  p.z = (u16*)take((size_t)T_ * ZLD * 2);
  p.vsT = (u16*)take((size_t)16 * 128 * S_ * 2);
  p.vwT = (u16*)take((size_t)16 * 128 * S_ * 2);
  p.vcT = (u16*)take((size_t)16 * 128 * 128 * 2);
  p.kcmp = (u16*)take((size_t)16 * 128 * 128 * 2);
  p.U = (u16*)take((size_t)T_ * 1024 * 2);
  p.a_arr = (float*)take((size_t)T_ * 1024 * 4);
  p.b_arr = (float*)take((size_t)T_ * 1024 * 4);
  p.csA = (float*)take((size_t)B_ * NCH * 1024 * 4);
  p.csH = (float*)take((size_t)B_ * NCH * 1024 * 4);
  p.bar = (unsigned*)take(XCD_BAR_WORDS * 4);
  p.rope_tab = (float*)take((size_t)2048 * 64 * 2 * 4);
  p.pe_b = (u16*)take((size_t)2 * 4096 * 2);
  p.cpart = (float*)take((size_t)128 * 128 * 128 * 4);
  p.keys_b = (u16*)take((size_t)16 * 128 * 128 * 2);
  p.orn = p.U;
  p.y = (u16*)p.a_arr;
  p.pq = (u16*)p.b_arr;
  p.down8 = (unsigned char*)p.z;
  p.up8 = (unsigned char*)p.z + (size_t)16384 * 1536;
  p.eidx = (int*)p.U;
  p.gw = (float*)(p.U + (size_t)T_ * 128 * 2);
  if (off > ws_size) fprintf(stderr, "workspace too small: need %zu have %zu\n", off, ws_size);
  (void)hipMemsetAsync(p.bar, 0, XCD_BAR_WORDS * 4, stream);
  void* args[] = {&p};
  hipError_t e = hipLaunchCooperativeKernel((void*)fwd_megakernel, dim3(grid_blocks), dim3(256), args, 0, stream);
  if (e != hipSuccess) fprintf(stderr, "cooperative launch failed: %s (grid %d)\n", hipGetErrorString(e), grid_blocks);
}
```

```cpp
#include <hip/hip_runtime.h>
#include <hip/hip_cooperative_groups.h>
#include <cstdio>
#include <cstdint>
namespace cg = cooperative_groups;

typedef unsigned short u16;
using bf16x8 = __attribute__((ext_vector_type(8))) short;
using f32x4 = __attribute__((ext_vector_type(4))) float;
using u16x4 = __attribute__((ext_vector_type(4))) unsigned short;
using u32x2 = __attribute__((ext_vector_type(2))) unsigned;
using u32x4 = __attribute__((ext_vector_type(4))) unsigned;

#define DEV __device__ __forceinline__

constexpr int S_ = 2048, D_ = 2048, B_ = 8, T_ = B_ * S_;
constexpr int NIN = 4632, ZLD = 4736;
constexpr int CQ = 0, CKC = 1024, CVC = 1280, CKS = 1536, CVS = 1792, CKW = 2048, CVW = 2304, CGL = 2560, CXR = 2584, CXG = 3608;
constexpr int SMEM_BYTES = 73728 + 256;
constexpr float QSCALE = 0.08838834764831845f * 1.4426950408889634f;
constexpr int NCH = 64;
constexpr int CHL = 32;

struct Params {
  const float *x, *c, *ada_w, *ada_b, *norm_mix_g, *norm_ffn_g, *w_in, *w_out, *q_norm_g, *k_norm_g;
  const float *cmp_pe_k, *cmp_pe_v, *cmp_w_k, *cmp_w_v, *gate_b, *conv_w, *conv_b, *lru_wa, *lru_ba;
  const float *lru_wi, *lru_bi, *lru_lam, *out_g_attn, *out_g_rnn, *peer_wq, *peer_keys, *peer_down, *peer_up;
  float* out;
  u16 *Wt_in, *Wt_out, *Wt_q, *Wt_ck, *Wt_cv, *Wt_g;
  float *cbias, *modpart, *mod;
  u16 *h, *oattn3, *z, *vsT, *vwT, *vcT, *kcmp, *U;
  float *a_arr, *b_arr, *csA, *csH;
  u16 *orn, *y, *pq;
  unsigned char *down8, *up8;
  int* eidx; float* gw;
  unsigned* bar;
  float* rope_tab;
  u16* pe_b;
  float* cpart;
  u16* keys_b;
};

DEV int ltid() { int t = threadIdx.x; asm volatile("" : "+v"(t)); return t; }
typedef float float2v __attribute__((ext_vector_type(2)));
typedef __bf16 bf16x2v __attribute__((ext_vector_type(2)));
DEV u16 f2bf(float f) { return __builtin_bit_cast(u16, (__bf16)f); }
DEV float bf2f(u16 h) { return __uint_as_float(((unsigned)h) << 16); }
DEV unsigned pack2(float a, float b) { float2v v = {a, b}; return __builtin_bit_cast(unsigned, __builtin_convertvector(v, bf16x2v)); }
DEV float bflo(unsigned u) { return __uint_as_float(u << 16); }
DEV float bfhi(unsigned u) { return __uint_as_float(u & 0xffff0000u); }
DEV float wave_sum(float v) {
#pragma unroll
  for (int o = 32; o; o >>= 1) v += __shfl_xor(v, o);
  return v;
}
DEV float sigmoidf_(float v) { return 1.f / (1.f + __expf(-v)); }
DEV float gelu_exact(float v) { return 0.5f * v * (1.f + erff(v * 0.7071067811865476f)); }

DEV void ph_modpart(const Params& p, int item, float* sm) {
  const int cb = item % 12, kc = item / 12, tid = ltid();
  for (int i = tid; i < 512; i += 256) {
    int b = i >> 6, k = i & 63;
    float v = p.c[b * 2048 + kc * 64 + k];
    sm[i] = v / (1.f + __expf(-v));
  }
  __syncthreads();
  const int col = cb * 1024 + tid * 4;
  float acc[8][4];
#pragma unroll
  for (int b = 0; b < 8; ++b) { acc[b][0] = acc[b][1] = acc[b][2] = acc[b][3] = 0.f; }
  const float* w = p.ada_w + (size_t)(kc * 64) * 12288 + col;
#pragma unroll 4
  for (int k = 0; k < 64; ++k) {
    float4 wv = *(const float4*)(w + (size_t)k * 12288);
#pragma unroll
    for (int b = 0; b < 8; ++b) {
      float s = sm[b * 64 + k];
      acc[b][0] += s * wv.x; acc[b][1] += s * wv.y; acc[b][2] += s * wv.z; acc[b][3] += s * wv.w;
    }
  }
#pragma unroll
  for (int b = 0; b < 8; ++b)
    *(float4*)(p.modpart + ((size_t)(kc * 8 + b)) * 12288 + col) = make_float4(acc[b][0], acc[b][1], acc[b][2], acc[b][3]);
  __syncthreads();
}

DEV void ph_transpose(const float* src, int K, int N, int Npad, u16* dst, int item, float* sm) {
  const int ntl = Npad / 64, kt = item / ntl, nti = item % ntl, tid = ltid();
  const int c4 = tid & 15, r0 = tid >> 4;
  float4 v[4];
#pragma unroll
  for (int ps = 0; ps < 4; ++ps) {
    const int k = ps * 16 + r0, n = nti * 64 + c4 * 4;
    v[ps] = (n < N) ? *(const float4*)(src + (size_t)(kt * 64 + k) * N + n) : make_float4(0.f, 0.f, 0.f, 0.f);
  }
#pragma unroll
  for (int ps = 0; ps < 4; ++ps) {
    const int k = ps * 16 + r0;
    sm[k * 65 + c4 * 4 + 0] = v[ps].x; sm[k * 65 + c4 * 4 + 1] = v[ps].y; sm[k * 65 + c4 * 4 + 2] = v[ps].z; sm[k * 65 + c4 * 4 + 3] = v[ps].w;
  }
  __syncthreads();
  {
    const int n = tid >> 2, q = tid & 3;
    u32x4 o0, o1;
#pragma unroll
    for (int e = 0; e < 4; ++e) {
      o0[e] = pack2(sm[(q * 16 + 2 * e) * 65 + n], sm[(q * 16 + 2 * e + 1) * 65 + n]);
      o1[e] = pack2(sm[(q * 16 + 8 + 2 * e) * 65 + n], sm[(q * 16 + 8 + 2 * e + 1) * 65 + n]);
    }
    u16* d = dst + (size_t)(nti * 64 + n) * K + kt * 64 + q * 16;
    *(u32x4*)d = o0; *(u32x4*)(d + 8) = o1;
  }
  __syncthreads();
}

DEV void ph_cbias(const Params& p, int which, float* sm) {
  const float* pe = which ? p.cmp_pe_v : p.cmp_pe_k;
  const float* W = which ? p.cmp_w_v : p.cmp_w_k;
  const int tid = ltid(), n = tid & 127, hf = tid >> 7;
  float acc = 0.f;
  for (int k = hf * 2048; k < hf * 2048 + 2048; ++k) acc += pe[k] * W[(size_t)k * 128 + n];
  sm[tid] = acc;
  __syncthreads();
  if (tid < 128) p.cbias[which * 128 + tid] = sm[tid] + sm[tid + 128];
  __syncthreads();
}

DEV void ph_adaln_row(const float* xin, const float* g, const float* mod, int sh_off, int sc_off, u16* hout, int row) {
  const int lane = ltid() & 63, b = row >> 11;
  const float* xr = xin + (size_t)row * 2048;
  float4 v[8];
  float ss = 0.f;
#pragma unroll
  for (int i = 0; i < 8; ++i) {
    v[i] = *(const float4*)(xr + i * 256 + lane * 4);
    ss += v[i].x * v[i].x + v[i].y * v[i].y + v[i].z * v[i].z + v[i].w * v[i].w;
  }
  ss = wave_sum(ss);
  const float rstd = rsqrtf(ss * (1.f / 2048.f) + 1e-6f);
  const float* mb = mod + (size_t)b * 12288;
#pragma unroll
  for (int i = 0; i < 8; ++i) {
    int col = i * 256 + lane * 4;
    float4 g4 = *(const float4*)(g + col);
    float4 sc = *(const float4*)(mb + sc_off + col);
    float4 sh = *(const float4*)(mb + sh_off + col);
    float y0 = v[i].x * rstd * g4.x * (1.f + sc.x) + sh.x;
    float y1 = v[i].y * rstd * g4.y * (1.f + sc.y) + sh.y;
    float y2 = v[i].z * rstd * g4.z * (1.f + sc.z) + sh.z;
    float y3 = v[i].w * rstd * g4.w * (1.f + sc.w) + sh.w;
    u32x2 pk; pk[0] = pack2(y0, y1); pk[1] = pack2(y2, y3);
    *(u32x2*)(hout + (size_t)row * 2048 + col) = pk;
  }
}

template <class AF, class EPI>
DEV void gemm_tile(AF aptr, const u16* Bt, int ldb, int K, EPI epi, char* smem) {
  const int tid = ltid(), wid = tid >> 6, lane = tid & 63, wr = wid >> 1, wc = wid & 1, fr = lane & 15, fq = lane >> 4;
  f32x4 acc[4][4];
#pragma unroll
  for (int m = 0; m < 4; ++m)
#pragma unroll
    for (int n = 0; n < 4; ++n) acc[m][n] = f32x4{0.f, 0.f, 0.f, 0.f};
  const int nk = K / 32;
  auto stage = [&](int kt, int buf) {
    char* SA = smem + buf * 16384;
    char* SB = SA + 8192;
#pragma unroll
    for (int i = 0; i < 2; ++i) {
      int bo = tid * 16 + i * 4096, r = bo >> 6, c = (bo & 63) >> 1;
      __builtin_amdgcn_global_load_lds((const unsigned*)aptr(r, kt * 32 + c), (__attribute__((address_space(3))) unsigned*)(SA + bo), 16, 0, 0);
      __builtin_amdgcn_global_load_lds((const unsigned*)(Bt + (size_t)r * ldb + kt * 32 + c), (__attribute__((address_space(3))) unsigned*)(SB + bo), 16, 0, 0);
    }
  };
  asm volatile("s_waitcnt vmcnt(0)" ::: "memory");
  __syncthreads();
  stage(0, 0);
  if (nk > 1) stage(1, 1);
  if (nk > 2) stage(2, 2);
  const unsigned lbase = (unsigned)(size_t)(const __attribute__((address_space(3))) char*)smem;
  const unsigned aoff = lbase + (wr * 64 + fr) * 64 + fq * 16, boff = lbase + 8192 + (wc * 64 + fr) * 64 + fq * 16;
  for (int t = 0; t < nk; ++t) {
    if (t + 2 < nk) asm volatile("s_waitcnt vmcnt(8)" ::: "memory");
    else if (t + 1 < nk) asm volatile("s_waitcnt vmcnt(4)" ::: "memory");
    else asm volatile("s_waitcnt vmcnt(0)" ::: "memory");
    __builtin_amdgcn_s_barrier();
    if (t + 3 < nk) stage(t + 3, (t + 3) & 3);
    const unsigned sa = aoff + (t & 3) * 16384, sb = boff + (t & 3) * 16384;
    u32x4 a0, a1, a2, a3, b0, b1, b2, b3;
    asm volatile("ds_read_b128 %0, %1" : "=v"(a0) : "v"(sa));
    asm volatile("ds_read_b128 %0, %1" : "=v"(b0) : "v"(sb));
    asm volatile("ds_read_b128 %0, %1 offset:1024" : "=v"(b1) : "v"(sb));
    asm volatile("ds_read_b128 %0, %1 offset:2048" : "=v"(b2) : "v"(sb));
    asm volatile("ds_read_b128 %0, %1 offset:3072" : "=v"(b3) : "v"(sb));
    asm volatile("ds_read_b128 %0, %1 offset:1024" : "=v"(a1) : "v"(sa));
    asm volatile("ds_read_b128 %0, %1 offset:2048" : "=v"(a2) : "v"(sa));
    asm volatile("ds_read_b128 %0, %1 offset:3072" : "=v"(a3) : "v"(sa));
    asm volatile("s_waitcnt lgkmcnt(0)" : "+v"(a0), "+v"(a1), "+v"(a2), "+v"(a3), "+v"(b0), "+v"(b1), "+v"(b2), "+v"(b3));
    bf16x8 At[4], Bv[4];
    At[0] = __builtin_bit_cast(bf16x8, a0); At[1] = __builtin_bit_cast(bf16x8, a1); At[2] = __builtin_bit_cast(bf16x8, a2); At[3] = __builtin_bit_cast(bf16x8, a3);
    Bv[0] = __builtin_bit_cast(bf16x8, b0); Bv[1] = __builtin_bit_cast(bf16x8, b1); Bv[2] = __builtin_bit_cast(bf16x8, b2); Bv[3] = __builtin_bit_cast(bf16x8, b3);
#pragma unroll
    for (int m = 0; m < 4; ++m)
#pragma unroll
      for (int n = 0; n < 4; ++n) acc[m][n] = __builtin_amdgcn_mfma_f32_16x16x32_bf16(At[m], Bv[n], acc[m][n], 0, 0, 0);
  }
  __syncthreads();
  {
    int fr2 = fr, fq2 = fq;
    asm volatile("" : "+v"(fr2), "+v"(fq2));
    epi(acc, wr, wc, fr2, fq2);
  }
}

template <class AF, class EPI>
DEV void gemm_tile256(AF aptr, const u16* Bt, int ldb, int K, EPI epi, char* smem) {
  const int tid = ltid(), wid = tid >> 6, lane = tid & 63, wr = wid >> 1, wc = wid & 1, fr = lane & 15, fq = lane >> 4;
  f32x4 acc[8][4];
#pragma unroll
  for (int m = 0; m < 8; ++m)
#pragma unroll
    for (int n = 0; n < 4; ++n) acc[m][n] = f32x4{0.f, 0.f, 0.f, 0.f};
  const int nk = K / 32;
  auto stage = [&](int kt, int buf) {
    char* SA = smem + buf * 24576;
    char* SB = SA + 16384;
#pragma unroll
    for (int i = 0; i < 4; ++i) {
      int bo = tid * 16 + i * 4096, r = bo >> 6, c = (bo & 63) >> 1;
      __builtin_amdgcn_global_load_lds((const unsigned*)aptr(r, kt * 32 + c), (__attribute__((address_space(3))) unsigned*)(SA + bo), 16, 0, 0);
    }
#pragma unroll
    for (int i = 0; i < 2; ++i) {
      int bo = tid * 16 + i * 4096, r = bo >> 6, c = (bo & 63) >> 1;
      __builtin_amdgcn_global_load_lds((const unsigned*)(Bt + (size_t)r * ldb + kt * 32 + c), (__attribute__((address_space(3))) unsigned*)(SB + bo), 16, 0, 0);
    }
  };
  asm volatile("s_waitcnt vmcnt(0)" ::: "memory");
  __syncthreads();
  stage(0, 0);
  stage(1, 1);
  const unsigned lbase = (unsigned)(size_t)(const __attribute__((address_space(3))) char*)smem;
  const unsigned aoff = lbase + (wr * 128 + fr) * 64 + fq * 16, boff = lbase + 16384 + (wc * 64 + fr) * 64 + fq * 16;
  int buf = 0;
#pragma unroll 1
  for (int t = 0; t < nk; ++t) {
    if (t + 1 < nk) asm volatile("s_waitcnt vmcnt(6)" ::: "memory");
    else asm volatile("s_waitcnt vmcnt(0)" ::: "memory");
    __builtin_amdgcn_s_barrier();
    if (t + 2 < nk) { int nb2 = buf + 2; if (nb2 >= 3) nb2 -= 3; stage(t + 2, nb2); }
    const unsigned sa = aoff + buf * 24576, sb = boff + buf * 24576;
    u32x4 a0, a1, a2, a3, a4, a5, a6, a7, b0, b1, b2, b3;
    asm volatile("ds_read_b128 %0, %1" : "=v"(b0) : "v"(sb));
    asm volatile("ds_read_b128 %0, %1 offset:1024" : "=v"(b1) : "v"(sb));
    asm volatile("ds_read_b128 %0, %1 offset:2048" : "=v"(b2) : "v"(sb));
    asm volatile("ds_read_b128 %0, %1 offset:3072" : "=v"(b3) : "v"(sb));
    asm volatile("ds_read_b128 %0, %1" : "=v"(a0) : "v"(sa));
    asm volatile("ds_read_b128 %0, %1 offset:1024" : "=v"(a1) : "v"(sa));
    asm volatile("ds_read_b128 %0, %1 offset:2048" : "=v"(a2) : "v"(sa));
    asm volatile("ds_read_b128 %0, %1 offset:3072" : "=v"(a3) : "v"(sa));
    asm volatile("ds_read_b128 %0, %1 offset:4096" : "=v"(a4) : "v"(sa));
    asm volatile("ds_read_b128 %0, %1 offset:5120" : "=v"(a5) : "v"(sa));
    asm volatile("ds_read_b128 %0, %1 offset:6144" : "=v"(a6) : "v"(sa));
    asm volatile("ds_read_b128 %0, %1 offset:7168" : "=v"(a7) : "v"(sa));
    asm volatile("s_waitcnt lgkmcnt(4)" : "+v"(a0), "+v"(a1), "+v"(a2), "+v"(a3), "+v"(b0), "+v"(b1), "+v"(b2), "+v"(b3));
    bf16x8 Bv[4];
    Bv[0] = __builtin_bit_cast(bf16x8, b0); Bv[1] = __builtin_bit_cast(bf16x8, b1); Bv[2] = __builtin_bit_cast(bf16x8, b2); Bv[3] = __builtin_bit_cast(bf16x8, b3);
    {
      bf16x8 At[4];
      At[0] = __builtin_bit_cast(bf16x8, a0); At[1] = __builtin_bit_cast(bf16x8, a1); At[2] = __builtin_bit_cast(bf16x8, a2); At[3] = __builtin_bit_cast(bf16x8, a3);
#pragma unroll
      for (int m = 0; m < 4; ++m)
#pragma unroll
        for (int n = 0; n < 4; ++n) acc[m][n] = __builtin_amdgcn_mfma_f32_16x16x32_bf16(At[m], Bv[n], acc[m][n], 0, 0, 0);
    }
    asm volatile("s_waitcnt lgkmcnt(0)" : "+v"(a4), "+v"(a5), "+v"(a6), "+v"(a7));
    {
      bf16x8 At[4];
      At[0] = __builtin_bit_cast(bf16x8, a4); At[1] = __builtin_bit_cast(bf16x8, a5); At[2] = __builtin_bit_cast(bf16x8, a6); At[3] = __builtin_bit_cast(bf16x8, a7);
#pragma unroll
      for (int m = 0; m < 4; ++m)
#pragma unroll
        for (int n = 0; n < 4; ++n) acc[4 + m][n] = __builtin_amdgcn_mfma_f32_16x16x32_bf16(At[m], Bv[n], acc[4 + m][n], 0, 0, 0);
    }
    buf = (buf == 2) ? 0 : buf + 1;
  }
  __syncthreads();
  {
    int fr2 = fr, fq2 = fq;
    asm volatile("" : "+v"(fr2), "+v"(fq2));
#pragma unroll
    for (int h = 0; h < 2; ++h) {
      auto stager = [&](float* smf_, int STR) {
        if (wr == h) {
#pragma unroll
          for (int m = 0; m < 8; ++m)
#pragma unroll
            for (int n = 0; n < 4; ++n)
#pragma unroll
              for (int j = 0; j < 4; ++j) smf_[(m * 16 + fq2 * 4 + j) * STR + wc * 64 + n * 16 + fr2] = acc[m][n][j];
        }
      };
      epi(stager, h);
    }
  }
}

DEV void ph_post_token(const Params& p, int row) {
  const int lane = ltid() & 63, pos = row & 2047;
  const float freq = exp2f(-(float)lane * (13.287712379549449f / 64.f));
  float sn, cs;
  sincosf((float)pos * freq, &sn, &cs);
  u16* zr = p.z + (size_t)row * ZLD;
  auto seg = [&](int col, const float* gn, float osc) {
    float x1 = bf2f(zr[col + lane]), x2 = bf2f(zr[col + 64 + lane]);
    if (gn) {
      float ss = wave_sum(x1 * x1 + x2 * x2);
      float r = rsqrtf(ss * (1.f / 128.f) + 1e-6f);
      x1 *= r * gn[lane]; x2 *= r * gn[lane + 64];
    }
    float o1 = x1 * cs - x2 * sn, o2 = x2 * cs + x1 * sn;
    zr[col + lane] = f2bf(o1 * osc); zr[col + 64 + lane] = f2bf(o2 * osc);
  };
  for (int hh = 0; hh < 8; ++hh) seg(CQ + hh * 128, p.q_norm_g, QSCALE);
  for (int g = 0; g < 2; ++g) {
    seg(CKC + g * 128, nullptr, 1.f);
    seg(CKS + g * 128, p.k_norm_g + 128, 1.f);
    seg(CKW + g * 128, p.k_norm_g + 256, 1.f);
  }
  const int ch0 = lane * 16;
  float u[16];
#pragma unroll
  for (int e = 0; e < 16; ++e) u[e] = p.conv_b[ch0 + e];
#pragma unroll
  for (int i = 0; i < 4; ++i) {
    int tt = pos - 3 + i;
    if (tt >= 0) {
      const u16* src = p.z + (size_t)(row - 3 + i) * ZLD + CXR + ch0;
      u32x4 a = *(const u32x4*)src, b2 = *(const u32x4*)(src + 8);
      const float* w = p.conv_w + i * 1024 + ch0;
#pragma unroll
      for (int e = 0; e < 4; ++e) {
        u[2 * e] += bflo(a[e]) * w[2 * e]; u[2 * e + 1] += bfhi(a[e]) * w[2 * e + 1];
        u[8 + 2 * e] += bflo(b2[e]) * w[8 + 2 * e]; u[8 + 2 * e + 1] += bfhi(b2[e]) * w[8 + 2 * e + 1];
      }
    }
  }
  u32x4 o0, o1;
#pragma unroll
  for (int e = 0; e < 4; ++e) { o0[e] = pack2(u[2 * e], u[2 * e + 1]); o1[e] = pack2(u[8 + 2 * e], u[8 + 2 * e + 1]); }
  u16* dst = p.U + (size_t)row * 1024 + ch0;
  *(u32x4*)dst = o0; *(u32x4*)(dst + 8) = o1;
}

template <int STR>
DEV void stage_acc_s(float* smf, f32x4 (&acc)[4][4], int wr, int wc, int fr, int fq) {
#pragma unroll
  for (int m = 0; m < 4; ++m)
#pragma unroll
    for (int n = 0; n < 4; ++n)
#pragma unroll
      for (int j = 0; j < 4; ++j) smf[(wr * 64 + m * 16 + fq * 4 + j) * STR + wc * 64 + n * 16 + fr] = acc[m][n][j];
}
DEV void stage_acc(float* smf, f32x4 (&acc)[4][4], int wr, int wc, int fr, int fq) {
#pragma unroll
  for (int m = 0; m < 4; ++m)
#pragma unroll
    for (int n = 0; n < 4; ++n)
#pragma unroll
      for (int j = 0; j < 4; ++j) smf[(wr * 64 + m * 16 + fq * 4 + j) * 129 + wc * 64 + n * 16 + fr] = acc[m][n][j];
}
DEV void store_row_bf16(const float* srow, u16* dst) {
#pragma unroll
  for (int q = 0; q < 8; ++q) {
    u32x4 o;
#pragma unroll
    for (int e = 0; e < 4; ++e) o[e] = pack2(srow[q * 8 + 2 * e], srow[q * 8 + 2 * e + 1]);
    *(u32x4*)(dst + q * 8) = o;
  }
}

DEV void ph_conv_tokens(const Params& p, int tok0) {
  const int lane = ltid() & 63, ch0 = lane * 16, pos0 = tok0 & 2047;
  float cw[4][16], cb[16];
#pragma unroll
  for (int q = 0; q < 4; ++q) {
    float4 v = *(const float4*)(p.conv_b + ch0 + q * 4);
    cb[q * 4] = v.x; cb[q * 4 + 1] = v.y; cb[q * 4 + 2] = v.z; cb[q * 4 + 3] = v.w;
#pragma unroll
    for (int i = 0; i < 4; ++i) {
      float4 w = *(const float4*)(p.conv_w + i * 1024 + ch0 + q * 4);
      cw[i][q * 4] = w.x; cw[i][q * 4 + 1] = w.y; cw[i][q * 4 + 2] = w.z; cw[i][q * 4 + 3] = w.w;
    }
  }
  u32x4 rows[11][2];
#pragma unroll
  for (int i = 0; i < 11; ++i) {
    const bool ok = (pos0 - 3 + i) >= 0;
    const u16* src = p.z + (size_t)(tok0 - 3 + i) * ZLD + CXR + ch0;
    rows[i][0] = ok ? *(const u32x4*)src : u32x4{0u, 0u, 0u, 0u};
    rows[i][1] = ok ? *(const u32x4*)(src + 8) : u32x4{0u, 0u, 0u, 0u};
  }
#pragma unroll
  for (int tk = 0; tk < 8; ++tk) {
    float u[16];
#pragma unroll
    for (int e = 0; e < 16; ++e) u[e] = cb[e];
#pragma unroll
    for (int i = 0; i < 4; ++i)
#pragma unroll
      for (int hh = 0; hh < 2; ++hh)
#pragma unroll
        for (int e = 0; e < 4; ++e) {
          const unsigned v = rows[tk + i][hh][e];
          u[hh * 8 + 2 * e] += bflo(v) * cw[i][hh * 8 + 2 * e];
          u[hh * 8 + 2 * e + 1] += bfhi(v) * cw[i][hh * 8 + 2 * e + 1];
        }
    u32x4 o0, o1;
#pragma unroll
    for (int e = 0; e < 4; ++e) { o0[e] = pack2(u[2 * e], u[2 * e + 1]); o1[e] = pack2(u[8 + 2 * e], u[8 + 2 * e + 1]); }
    u16* dst = p.U + (size_t)(tok0 + tk) * 1024 + ch0;
    *(u32x4*)dst = o0; *(u32x4*)(dst + 8) = o1;
  }
}

DEV void ph_vtrans(const Params& p, int item, char* smem) {
  const int tid = ltid();
  const int tt = item & 31, which = (item >> 5) & 1, bg = item >> 6, b = bg >> 1, g = bg & 1;
  u16* sm = (u16*)smem;
  const u16* src = p.z + (size_t)(b * S_ + tt * 64) * ZLD + (which ? CVW : CVS) + g * 128;
  __syncthreads();
#pragma unroll
  for (int i = 0; i < 4; ++i) {
    int id = tid + i * 256, r = id >> 4, c16 = id & 15;
    u32x4 v = *(const u32x4*)(src + (size_t)r * ZLD + c16 * 8);
    *(u32x4*)(sm + r * 136 + c16 * 8) = v;
  }
  __syncthreads();
  u16* dstb = (which ? p.vwT : p.vsT) + (size_t)bg * 128 * S_ + tt * 64;
#pragma unroll
  for (int i = 0; i < 4; ++i) {
    int id = tid + i * 256, d = id >> 3, c8 = id & 7;
    u32x4 o;
#pragma unroll
    for (int e = 0; e < 4; ++e) {
      unsigned lo = sm[(c8 * 8 + 2 * e) * 136 + d], hi = sm[(c8 * 8 + 2 * e + 1) * 136 + d];
      o[e] = lo | (hi << 16);
    }
    *(u32x4*)(dstb + (size_t)d * S_ + c8 * 8) = o;
  }
}

DEV bf16x8 pack_p(const f32x4& a, const f32x4& b) {
  u32x4 r;
  r[0] = pack2(a[0], a[1]); r[1] = pack2(a[2], a[3]); r[2] = pack2(b[0], b[1]); r[3] = pack2(b[2], b[3]);
  return __builtin_bit_cast(bf16x8, r);
}
DEV bf16x8 ld2x64(const u16* p0, const u16* p1) {
  u32x2 a = *(const u32x2*)p0, b = *(const u32x2*)p1;
  u32x4 r; r[0] = a[0]; r[1] = a[1]; r[2] = b[0]; r[3] = b[1];
  return __builtin_bit_cast(bf16x8, r);
}

DEV void attn_item(const Params& p, int item, char* smem) {
  int tid_ = threadIdx.x;
  asm volatile("" : "+v"(tid_));
  const int tid = tid_, lane = tid & 63, w = __builtin_amdgcn_readfirstlane(tid >> 6), lq = lane & 15, g4 = lane >> 4;
  const int bg = item & 15, qt32 = 63 - (item >> 4), b = bg >> 1, g = bg & 1;
  const int t0 = qt32 * 32, cur = t0 >> 6, hq = g * 4 + w;
  u16* Ks = (u16*)smem;
  u16* Vs = (u16*)(smem + 34816);
  float* impP = (float*)smem;
  float* impT = (float*)(smem + 34816);
  unsigned* selmask = (unsigned*)(smem + 69632);
  const u16* zb = p.z + (size_t)(b * S_) * ZLD;
  const float NEG_INF = -__builtin_inff();

  bf16x8 qf[2][4];
#pragma unroll
  for (int qt = 0; qt < 2; ++qt)
#pragma unroll
    for (int ks = 0; ks < 4; ++ks)
      qf[qt][ks] = *(const bf16x8*)(zb + (size_t)(t0 + qt * 16 + lq) * ZLD + CQ + hq * 128 + ks * 32 + g4 * 8);
  auto gatef = [&](int qt, int br) -> float {
    return sigmoidf_(bf2f(zb[(size_t)(t0 + qt * 16 + lq) * ZLD + CGL + hq * 3 + br]) + p.gate_b[hq * 3 + br]);
  };

  __builtin_amdgcn_sched_barrier(0);
  const size_t orow0 = (size_t)(b * S_ + t0 + lq) * 1024 + hq * 128 + g4 * 4;
  const bool need_sel = (cur >= 16);

  __syncthreads();
  {
    const u16* ksrc = p.kcmp + (size_t)bg * 128 * 128;
    const u16* vsrc = p.vcT + (size_t)bg * 128 * 128;
#pragma unroll
    for (int i = 0; i < 8; ++i) {
      int id = tid + i * 256, r = id >> 4, c16 = id & 15;
      *(u32x4*)(Ks + r * 136 + c16 * 8) = *(const u32x4*)(ksrc + r * 128 + c16 * 8);
      *(u32x4*)(Vs + r * 136 + c16 * 8) = *(const u32x4*)(vsrc + r * 128 + c16 * 8);
    }
    if (tid < 64) selmask[tid] = (tid == 33) ? 0xFFFFFFFFu : 0u;
  }
  __syncthreads();
  float impown[2][8];
#pragma unroll
  for (int qt = 0; qt < 2; ++qt) {
    __builtin_amdgcn_sched_barrier(0);
    f32x4 s[8];
#pragma unroll
    for (int kt = 0; kt < 8; ++kt) s[kt] = f32x4{0.f, 0.f, 0.f, 0.f};
#pragma unroll
    for (int kt = 0; kt < 8; ++kt)
#pragma unroll
      for (int ks = 0; ks < 4; ++ks) {
        bf16x8 a = *(const bf16x8*)(Ks + (kt * 16 + lq) * 136 + ks * 32 + g4 * 8);
        s[kt] = __builtin_amdgcn_mfma_f32_16x16x32_bf16(a, qf[qt][ks], s[kt], 0, 0, 0);
      }
    const int t = t0 + qt * 16 + lq;
    int cmax = (t >= 31) ? ((t - 31) >> 4) : -1;
    if (cmax > 126) cmax = 126;
    float mx = NEG_INF;
#pragma unroll
    for (int kt = 0; kt < 8; ++kt)
#pragma unroll
      for (int j = 0; j < 4; ++j) {
        int c = kt * 16 + g4 * 4 + j;
        float v = (c <= cmax) ? s[kt][j] : NEG_INF;
        s[kt][j] = v; mx = fmaxf(mx, v);
      }
    mx = fmaxf(mx, __shfl_xor(mx, 16)); mx = fmaxf(mx, __shfl_xor(mx, 32));
    const float mu = (mx == NEG_INF) ? 0.f : mx;
    float sum = 0.f;
#pragma unroll
    for (int kt = 0; kt < 8; ++kt)
#pragma unroll
      for (int j = 0; j < 4; ++j) { float pv = exp2f(s[kt][j] - mu); s[kt][j] = pv; sum += pv; }
    sum += __shfl_xor(sum, 16); sum += __shfl_xor(sum, 32);
    const float inv = (sum > 0.f) ? 1.f / sum : 0.f;
#pragma unroll
    for (int kt = 0; kt < 8; ++kt)
#pragma unroll
      for (int j = 0; j < 4; ++j) s[kt][j] *= inv;
    float spl[8];
#pragma unroll
    for (int kt = 0; kt < 8; ++kt) spl[kt] = 0.5f * s[kt][3];
#pragma unroll
    for (int kt = 0; kt < 8; ++kt) {
      float own = s[kt][0] + s[kt][1] + s[kt][2] + spl[kt];
      float up = __shfl(spl[kt], (lane + 48) & 63);
      float upprev = (kt > 0) ? __shfl(spl[kt > 0 ? kt - 1 : 0], (lane + 48) & 63) : 0.f;
      impown[qt][kt] = own + (g4 ? up : upprev);
    }
    __builtin_amdgcn_sched_barrier(0);
    f32x4 o[8];
#pragma unroll
    for (int dt = 0; dt < 8; ++dt) o[dt] = f32x4{0.f, 0.f, 0.f, 0.f};
#pragma unroll
    for (int m = 0; m < 4; ++m) {
      bf16x8 pb = pack_p(s[2 * m], s[2 * m + 1]);
#pragma unroll
      for (int dt = 0; dt < 8; ++dt) {
        const u16* vr = Vs + (dt * 16 + lq) * 136 + 32 * m + 4 * g4;
        bf16x8 a = ld2x64(vr, vr + 16);
        o[dt] = __builtin_amdgcn_mfma_f32_16x16x32_bf16(a, pb, o[dt], 0, 0, 0);
      }
    }
    __builtin_amdgcn_sched_barrier(0);
    u16* od = p.oattn3 + orow0 + (size_t)qt * 16 * 1024;
    const float gc = gatef(qt, 0);
#pragma unroll
    for (int dt = 0; dt < 8; ++dt) {
      u32x2 pk; pk[0] = pack2(o[dt][0] * gc, o[dt][1] * gc); pk[1] = pack2(o[dt][2] * gc, o[dt][3] * gc);
      *(u32x2*)(od + dt * 16) = pk;
    }
  }
  __syncthreads();
  if (need_sel) {
#pragma unroll
    for (int qt = 0; qt < 2; ++qt)
#pragma unroll
      for (int kt = 0; kt < 8; ++kt) impP[(w * 32 + qt * 16 + lq) * 32 + kt * 4 + g4] = impown[qt][kt];
  }
  __syncthreads();
  {
    const int q = tid >> 3, sub = tid & 7;
    if (need_sel) {
#pragma unroll
      for (int jj = 0; jj < 4; ++jj) {
        int j = sub * 4 + jj;
        impT[q * 32 + j] = impP[(0 * 32 + q) * 32 + j] + impP[(1 * 32 + q) * 32 + j] + impP[(2 * 32 + q) * 32 + j] + impP[(3 * 32 + q) * 32 + j];
      }
    }
    __syncthreads();
    unsigned m = 0u;
    if (!need_sel) {
      if (sub == 0) m = (cur + 1 >= 32) ? 0xffffffffu : ((1u << (cur + 1)) - 1u);
    } else {
      for (int jj = 0; jj < 4; ++jj) {
        int j = sub * 4 + jj;
        bool forced = (j == 0) || (j == cur) || (j == cur - 1);
        if (forced) { m |= 1u << j; continue; }
        if (j < 1 || j > cur - 2) continue;
        float mine = impT[q * 32 + j];
        int rank = 0;
        for (int j2 = 1; j2 <= cur - 2; ++j2) {
          float o2 = impT[q * 32 + j2];
          rank += (o2 > mine || (o2 == mine && j2 < j)) ? 1 : 0;
        }
        if (rank < 13) m |= 1u << j;
      }
    }
    if (m) { atomicOr(&selmask[q], m); atomicOr(&selmask[32], m); }
  }
  __syncthreads();
  if (tid < 32) atomicAnd(&selmask[33], selmask[tid]);
  __syncthreads();
  const unsigned umask = selmask[32], amask = selmask[33];
  const unsigned smq0 = selmask[lq], smq1 = selmask[16 + lq];

#pragma unroll 1
  for (int br = 1; br <= 2; ++br) {
    f32x4 o[2][8];
#pragma unroll
    for (int qt = 0; qt < 2; ++qt)
#pragma unroll
      for (int dt = 0; dt < 8; ++dt) o[qt][dt] = f32x4{0.f, 0.f, 0.f, 0.f};
    float lrun[2] = {0.f, 0.f};
    float Mb;
    {
      const float* kg = p.k_norm_g + br * 128;
      float gq = fmaxf(fabsf(p.q_norm_g[lane]), fabsf(p.q_norm_g[lane + 64]));
      float gk = fmaxf(fabsf(kg[lane]), fabsf(kg[lane + 64]));
#pragma unroll
      for (int o2 = 32; o2; o2 >>= 1) { gq = fmaxf(gq, __shfl_xor(gq, o2)); gk = fmaxf(gk, __shfl_xor(gk, o2)); }
      Mb = 128.f * QSCALE * gq * gk * 1.02f;
    }
    int jlo = 0;
    if (br == 2) { jlo = (t0 >= 511) ? ((t0 - 511) >> 6) : 0; }
    const int kcol = (br == 1 ? CKS : CKW) + g * 128;
    const u16* vT = (br == 1 ? p.vsT : p.vwT) + (size_t)bg * 128 * S_;
    u32x4 kreg[4], vreg[4];
    auto tload = [&](int jj) {
#pragma unroll
      for (int i = 0; i < 4; ++i) {
        int id = tid + i * 256;
        int r = id >> 4, c16 = id & 15;
        kreg[i] = *(const u32x4*)(zb + (size_t)(jj * 64 + r) * ZLD + kcol + c16 * 8);
        int d = id >> 3, c8 = id & 7;
        vreg[i] = *(const u32x4*)(vT + (size_t)d * S_ + jj * 64 + c8 * 8);
      }
    };
    tload(jlo);
    int j = jlo;
#pragma unroll 1
    while (j <= cur) {
      __syncthreads();
#pragma unroll
      for (int i = 0; i < 4; ++i) {
        int id = tid + i * 256;
        int r = id >> 4, c16 = id & 15;
        *(u32x4*)(Ks + r * 136 + c16 * 8) = kreg[i];
        int d = id >> 3, c8 = id & 7;
        *(u32x4*)(Vs + d * 72 + c8 * 8) = vreg[i];
      }
      __syncthreads();
      int jn = j + 1;
      if (br == 1) { const unsigned mm = (j >= 31) ? 0u : (umask >> (j + 1)); jn = mm ? (j + 1 + __builtin_ctz(mm)) : (cur + 1); }
      if (jn <= cur) tload(jn);
      const int jcur = j;
      const bool need_mask = (jcur == cur) || (br == 1 ? !((amask >> jcur) & 1u) : (jcur <= jlo + 1));
      const bool sel_only = (br == 1) && (jcur < cur);
      __builtin_amdgcn_sched_barrier(0);
      f32x4 s[2][4];
#pragma unroll
      for (int qt = 0; qt < 2; ++qt)
#pragma unroll
        for (int kt = 0; kt < 4; ++kt) s[qt][kt] = f32x4{0.f, 0.f, 0.f, 0.f};
#pragma unroll
      for (int kt = 0; kt < 4; ++kt)
#pragma unroll
        for (int ks = 0; ks < 4; ++ks) {
          if (ks == 0 && (kt & 1) == 0) __builtin_amdgcn_sched_barrier(0);
          bf16x8 a = *(const bf16x8*)(Ks + (kt * 16 + lq) * 136 + ks * 32 + g4 * 8);
          s[0][kt] = __builtin_amdgcn_mfma_f32_16x16x32_bf16(a, qf[0][ks], s[0][kt], 0, 0, 0);
          s[1][kt] = __builtin_amdgcn_mfma_f32_16x16x32_bf16(a, qf[1][ks], s[1][kt], 0, 0, 0);
        }
      bf16x8 pb[2][2];
#pragma unroll
      for (int qt = 0; qt < 2; ++qt) {
        __builtin_amdgcn_sched_barrier(0);
        const int t = t0 + qt * 16 + lq;
        const bool sel = (br == 2) || (((qt ? smq1 : smq0) >> jcur) & 1u);
        if (need_mask && sel_only) {
#pragma unroll
          for (int kt = 0; kt < 4; ++kt)
#pragma unroll
            for (int jj = 0; jj < 4; ++jj) s[qt][kt][jj] = sel ? s[qt][kt][jj] : NEG_INF;
        } else if (need_mask) {
#pragma unroll
          for (int kt = 0; kt < 4; ++kt)
#pragma unroll
            for (int jj = 0; jj < 4; ++jj) {
              int key = jcur * 64 + kt * 16 + g4 * 4 + jj;
              bool ok = sel && (key <= t) && (br == 1 || key > t - 512);
              s[qt][kt][jj] = ok ? s[qt][kt][jj] : NEG_INF;
            }
        }
        float sum = 0.f;
#pragma unroll
        for (int kt = 0; kt < 4; ++kt)
#pragma unroll
          for (int jj = 0; jj < 4; ++jj) { float pv = __builtin_amdgcn_exp2f(s[qt][kt][jj] - Mb); s[qt][kt][jj] = pv; sum += pv; }
        lrun[qt] += sum;
        pb[qt][0] = pack_p(s[qt][0], s[qt][1]);
        pb[qt][1] = pack_p(s[qt][2], s[qt][3]);
      }
      __builtin_amdgcn_sched_barrier(0);
#pragma unroll
      for (int m = 0; m < 2; ++m)
#pragma unroll
        for (int dt = 0; dt < 8; ++dt) {
          if (dt == 0 || dt == 4) __builtin_amdgcn_sched_barrier(0);
          const u16* vr = Vs + (dt * 16 + lq) * 72 + 32 * m + 4 * g4;
          bf16x8 a = ld2x64(vr, vr + 16);
          o[0][dt] = __builtin_amdgcn_mfma_f32_16x16x32_bf16(a, pb[0][m], o[0][dt], 0, 0, 0);
          o[1][dt] = __builtin_amdgcn_mfma_f32_16x16x32_bf16(a, pb[1][m], o[1][dt], 0, 0, 0);
        }
      j = jn;
    }
    __syncthreads();
    u16* stg = Ks + w * (32 * 136);
#pragma unroll
    for (int qt = 0; qt < 2; ++qt) {
      float l = lrun[qt];
      l += __shfl_xor(l, 16); l += __shfl_xor(l, 32);
      const float sc = (l > 0.f) ? gatef(qt, br) / l : 0.f;
#pragma unroll
      for (int dt = 0; dt < 8; ++dt) {
        u32x2 pk; pk[0] = pack2(o[qt][dt][0] * sc, o[qt][dt][1] * sc); pk[1] = pack2(o[qt][dt][2] * sc, o[qt][dt][3] * sc);
        *(u32x2*)(stg + (qt * 16 + lq) * 136 + dt * 16 + g4 * 4) = pk;
      }
    }
    {
      u16* ob = p.oattn3 + (size_t)br * T_ * 1024 + (size_t)(b * S_ + t0) * 1024 + hq * 128;
#pragma unroll 2
      for (int i = 0; i < 8; ++i) {
        const int idx = lane + i * 64, row = idx >> 4, c16 = idx & 15;
        const u32x4 v = *(const u32x4*)(stg + row * 136 + c16 * 8);
        *(u32x4*)(ob + (size_t)row * 1024 + c16 * 8) = v;
      }
    }
  }
}

DEV void ph_scan1(const Params& p, int item) {
  const int b = item / NCH, c = item % NCH, ch = ltid() * 4;
  const size_t base = (size_t)(b * S_ + c * CHL) * 1024 + ch;
  float A[4] = {1.f, 1.f, 1.f, 1.f}, H[4] = {0.f, 0.f, 0.f, 0.f};
#pragma unroll 8
  for (int t = 0; t < CHL; ++t) {
    float4 a = *(const float4*)(p.a_arr + base + (size_t)t * 1024);
    float4 bb = *(const float4*)(p.b_arr + base + (size_t)t * 1024);
    A[0] *= a.x; A[1] *= a.y; A[2] *= a.z; A[3] *= a.w;
    H[0] = a.x * H[0] + bb.x; H[1] = a.y * H[1] + bb.y; H[2] = a.z * H[2] + bb.z; H[3] = a.w * H[3] + bb.w;
  }
  *(float4*)(p.csA + (size_t)item * 1024 + ch) = make_float4(A[0], A[1], A[2], A[3]);
  *(float4*)(p.csH + (size_t)item * 1024 + ch) = make_float4(H[0], H[1], H[2], H[3]);
}
DEV void ph_scan2(const Params& p, int item) {
  const int b = item / NCH, c = item % NCH, ch = ltid() * 4;
  float H[4] = {0.f, 0.f, 0.f, 0.f};
  for (int c2 = 0; c2 < c; ++c2) {
    float4 a = *(const float4*)(p.csA + (size_t)(b * NCH + c2) * 1024 + ch);
    float4 hh = *(const float4*)(p.csH + (size_t)(b * NCH + c2) * 1024 + ch);
    H[0] = a.x * H[0] + hh.x; H[1] = a.y * H[1] + hh.y; H[2] = a.z * H[2] + hh.z; H[3] = a.w * H[3] + hh.w;
  }
  const size_t row0 = (size_t)(b * S_ + c * CHL);
#pragma unroll 8
  for (int t = 0; t < CHL; ++t) {
    float4 a = *(const float4*)(p.a_arr + (row0 + t) * 1024 + ch);
    float4 bb = *(const float4*)(p.b_arr + (row0 + t) * 1024 + ch);
    u32x2 xg = *(const u32x2*)(p.z + (row0 + t) * ZLD + CXG + ch);
    H[0] = a.x * H[0] + bb.x; H[1] = a.y * H[1] + bb.y; H[2] = a.z * H[2] + bb.z; H[3] = a.w * H[3] + bb.w;
    u32x2 pk;
    pk[0] = pack2(gelu_exact(bflo(xg[0])) * H[0], gelu_exact(bfhi(xg[0])) * H[1]);
    pk[1] = pack2(gelu_exact(bflo(xg[1])) * H[2], gelu_exact(bfhi(xg[1])) * H[3]);
    *(u32x2*)(p.orn + (row0 + t) * 1024 + ch) = pk;
  }
}

DEV void ph_ynorm_row(const Params& p, int row) {
  const int lane = ltid() & 63, c0 = lane * 16;
  float va[16], vr[16];
#pragma unroll
  for (int e = 0; e < 16; ++e) va[e] = 0.f;
#pragma unroll
  for (int br = 0; br < 3; ++br) {
    const u16* src = p.oattn3 + (size_t)br * T_ * 1024 + (size_t)row * 1024 + c0;
    u32x4 a = *(const u32x4*)src, b2 = *(const u32x4*)(src + 8);
#pragma unroll
    for (int e = 0; e < 4; ++e) { va[2 * e] += bflo(a[e]); va[2 * e + 1] += bfhi(a[e]); va[8 + 2 * e] += bflo(b2[e]); va[8 + 2 * e + 1] += bfhi(b2[e]); }
  }
  {
    const u16* src = p.orn + (size_t)row * 1024 + c0;
    u32x4 a = *(const u32x4*)src, b2 = *(const u32x4*)(src + 8);
#pragma unroll
    for (int e = 0; e < 4; ++e) { vr[2 * e] = bflo(a[e]); vr[2 * e + 1] = bfhi(a[e]); vr[8 + 2 * e] = bflo(b2[e]); vr[8 + 2 * e + 1] = bfhi(b2[e]); }
  }
  float sa = 0.f, sr = 0.f;
#pragma unroll
  for (int e = 0; e < 16; ++e) { sa += va[e] * va[e]; sr += vr[e] * vr[e]; }
  sa = wave_sum(sa); sr = wave_sum(sr);
  const float ra = rsqrtf(sa * (1.f / 1024.f) + 1e-6f), rr = rsqrtf(sr * (1.f / 1024.f) + 1e-6f);
  u32x4 o0, o1, o2, o3;
#pragma unroll
  for (int e = 0; e < 4; ++e) {
    o0[e] = pack2(va[2 * e] * ra * p.out_g_attn[c0 + 2 * e], va[2 * e + 1] * ra * p.out_g_attn[c0 + 2 * e + 1]);
    o1[e] = pack2(va[8 + 2 * e] * ra * p.out_g_attn[c0 + 8 + 2 * e], va[8 + 2 * e + 1] * ra * p.out_g_attn[c0 + 8 + 2 * e + 1]);
    o2[e] = pack2(vr[2 * e] * rr * p.out_g_rnn[c0 + 2 * e], vr[2 * e + 1] * rr * p.out_g_rnn[c0 + 2 * e + 1]);
    o3[e] = pack2(vr[8 + 2 * e] * rr * p.out_g_rnn[c0 + 8 + 2 * e], vr[8 + 2 * e + 1] * rr * p.out_g_rnn[c0 + 8 + 2 * e + 1]);
  }
  u16* dst = p.y + (size_t)row * 2048;
  *(u32x4*)(dst + c0) = o0; *(u32x4*)(dst + c0 + 8) = o1;
  *(u32x4*)(dst + 1024 + c0) = o2; *(u32x4*)(dst + 1024 + c0 + 8) = o3;
}

DEV void peer_route_item(const Params& p, int item, char* smem) {
  int tid_ = threadIdx.x;
  asm volatile("" : "+v"(tid_));
  const int tid = tid_, lane = tid & 63, w = tid >> 6, lq = lane & 15, g4 = lane >> 4;
  const int hh = item >> 8, tt = item & 255;
  const int tokL = w * 16 + lq, tok = tt * 64 + tokL;
  u16* Ks = (u16*)smem;
  float* topv = (float*)(smem + 34816);
  int* topi = (int*)(smem + 34816 + 8192);
  float* cvs = (float*)(smem + 34816 + 16384);
  int* candA = (int*)(smem + 34816 + 16384 + 13056);
  int* candB = candA + 50;
  const float NEG_INF = -__builtin_inff();
#pragma unroll 1
  for (int ph = 0; ph < 2; ++ph) {
    __syncthreads();
    {
      const u16* ksrc = p.keys_b + (size_t)(hh * 2 + ph) * 128 * 128;
      u32x4 kv[8];
#pragma unroll
      for (int i = 0; i < 8; ++i) { int id = tid + i * 256; kv[i] = *(const u32x4*)(ksrc + (size_t)(id >> 4) * 128 + (id & 15) * 8); }
#pragma unroll
      for (int i = 0; i < 8; ++i) { int id = tid + i * 256; *(u32x4*)(Ks + (id >> 4) * 136 + (id & 15) * 8) = kv[i]; }
      if (ph == 0 && tid < 50) {
        int c = tid, a = 0, off = 0;
        while (true) { int cnt = 16 / (a + 1); if (c < off + cnt) break; off += cnt; ++a; }
        candA[tid] = a; candB[tid] = c - off;
      }
    }
    __syncthreads();
    bf16x8 qf[4];
#pragma unroll
    for (int ks = 0; ks < 4; ++ks) qf[ks] = *(const bf16x8*)(p.pq + (size_t)tok * 2048 + hh * 256 + ph * 128 + ks * 32 + g4 * 8);
    f32x4 s[8];
#pragma unroll
    for (int kt = 0; kt < 8; ++kt) s[kt] = f32x4{0.f, 0.f, 0.f, 0.f};
#pragma unroll
    for (int kt = 0; kt < 8; ++kt)
#pragma unroll
      for (int ks = 0; ks < 4; ++ks) {
        bf16x8 a = *(const bf16x8*)(Ks + (kt * 16 + lq) * 136 + ks * 32 + g4 * 8);
        s[kt] = __builtin_amdgcn_mfma_f32_16x16x32_bf16(a, qf[ks], s[kt], 0, 0, 0);
      }
    unsigned r[32];
#pragma unroll
    for (int kt = 0; kt < 8; ++kt)
#pragma unroll
      for (int j = 0; j < 4; ++j) {
        const unsigned bits = __float_as_uint(s[kt][j]);
        const unsigned srt = bits ^ (((int)bits >> 31) | 0x80000000u);
        r[kt * 4 + j] = (srt & 0xFFFFFF80u) | (unsigned)(127 - (kt * 16 + g4 * 4 + j));
      }
#pragma unroll
    for (int k = 2; k <= 32; k <<= 1)
#pragma unroll
      for (int j = k >> 1; j > 0; j >>= 1)
#pragma unroll
        for (int i = 0; i < 32; ++i) {
          const int l = i ^ j;
          if (l > i) {
            const bool desc = ((i & k) == 0);
            const unsigned a = r[i], b2 = r[l];
            const unsigned hi = max(a, b2), lo = min(a, b2);
            r[i] = desc ? hi : lo; r[l] = desc ? lo : hi;
          }
        }
#pragma unroll 1
    for (int it = 0; it < 16; ++it) {
      unsigned mx = r[0];
      mx = max(mx, (unsigned)__shfl_xor((int)mx, 16)); mx = max(mx, (unsigned)__shfl_xor((int)mx, 32));
      const bool own = (r[0] == mx);
#pragma unroll
      for (int i = 0; i < 15; ++i) r[i] = own ? r[i + 1] : r[i];
      r[15] = own ? 0u : r[15];
      if (g4 == 0) {
        const unsigned srt = mx & 0xFFFFFF80u;
        const unsigned bits = srt ^ ((srt & 0x80000000u) ? 0x80000000u : 0xFFFFFFFFu);
        topv[(tokL * 2 + ph) * 16 + it] = __uint_as_float(bits);
        topi[(tokL * 2 + ph) * 16 + it] = 127 - (int)(mx & 127u);
      }
    }
  }
  __syncthreads();
  const int tl = tid >> 2, sub = tid & 3;
  unsigned* cvu = (unsigned*)cvs;
  unsigned mine[13];
#pragma unroll
  for (int i = 0; i < 13; ++i) {
    const int c = sub + 4 * i;
    mine[i] = 0xFFFFFFFFu;
    if (c < 50) {
      const float v = topv[(tl * 2 + 0) * 16 + candA[c]] + topv[(tl * 2 + 1) * 16 + candB[c]];
      const unsigned bits = __float_as_uint(v);
      const unsigned srt = bits ^ (((int)bits >> 31) | 0x80000000u);
      const unsigned pk = (srt & 0xFFFFFFC0u) | (unsigned)(63 - c);
      cvu[tl * 51 + c] = pk; mine[i] = pk;
    }
  }
  __syncthreads();
  {
    int rank[13];
#pragma unroll
    for (int i = 0; i < 13; ++i) rank[i] = 0;
#pragma unroll 5
    for (int c2 = 0; c2 < 50; ++c2) {
      const unsigned o = cvu[tl * 51 + c2];
#pragma unroll
      for (int i = 0; i < 13; ++i) rank[i] += (o > mine[i]) ? 1 : 0;
    }
    auto unpk = [](unsigned pk) -> float {
      const unsigned srt = pk & 0xFFFFFFC0u;
      return __uint_as_float(srt ^ ((srt & 0x80000000u) ? 0x80000000u : 0xFFFFFFFFu));
    };
    const float vmax = unpk(cvu[tl * 51]);
    float wpart = 0.f;
    float ev[13];
#pragma unroll
    for (int i = 0; i < 13; ++i) {
      ev[i] = 0.f;
      if (sub + 4 * i < 50 && rank[i] < 16) { ev[i] = __expf(unpk(mine[i]) - vmax); wpart += ev[i]; }
    }
    float wsum = wpart + __shfl_xor(wpart, 1);
    wsum += __shfl_xor(wsum, 2);
    const float winv = 1.f / wsum;
    const size_t ob = (size_t)(tt * 64 + tl) * 128 + hh * 16;
#pragma unroll
    for (int i = 0; i < 13; ++i) {
      const int c = sub + 4 * i;
      if (c < 50 && rank[i] < 16) {
        p.eidx[ob + rank[i]] = topi[(tl * 2 + 0) * 16 + candA[c]] * 128 + topi[(tl * 2 + 1) * 16 + candB[c]];
        p.gw[ob + rank[i]] = ev[i] * winv;
      }
    }
  }
}

DEV float dpp_row_sum(float v) {
  v += __builtin_bit_cast(float, __builtin_amdgcn_update_dpp(0, __builtin_bit_cast(int, v), 0xB1, 0xF, 0xF, true));
  v += __builtin_bit_cast(float, __builtin_amdgcn_update_dpp(0, __builtin_bit_cast(int, v), 0x4E, 0xF, 0xF, true));
  v += __builtin_bit_cast(float, __builtin_amdgcn_update_dpp(0, __builtin_bit_cast(int, v), 0x141, 0xF, 0xF, true));
  v += __builtin_bit_cast(float, __builtin_amdgcn_update_dpp(0, __builtin_bit_cast(int, v), 0x140, 0xF, 0xF, true));
  return v;
}
DEV float wave_sum_fast(float v) {
  v = dpp_row_sum(v);
  int iv = __builtin_bit_cast(int, v);
  float s0 = __builtin_bit_cast(float, __builtin_amdgcn_readlane(iv, 0));
  float s1 = __builtin_bit_cast(float, __builtin_amdgcn_readlane(iv, 16));
  float s2 = __builtin_bit_cast(float, __builtin_amdgcn_readlane(iv, 32));
  float s3 = __builtin_bit_cast(float, __builtin_amdgcn_readlane(iv, 48));
  return (s0 + s1) + (s2 + s3);
}
constexpr float DOWN_SCALE = 64.f, UP_SCALE = 4.f;

typedef float v32f __attribute__((ext_vector_type(32)));
typedef float v16f __attribute__((ext_vector_type(16)));
typedef unsigned v6u __attribute__((ext_vector_type(6)));
constexpr int ROW6 = 1536;

DEV void peer_gather_token(const Params& p, int tok) {
  const int lane = ltid() & 63, b = tok >> 11;
  float hx[32], acc[32];
  {
    const u16* hr = p.h + (size_t)tok * 2048 + lane * 32;
#pragma unroll
    for (int q = 0; q < 4; ++q) {
      u32x4 v = *(const u32x4*)(hr + q * 8);
#pragma unroll
      for (int e = 0; e < 4; ++e) { hx[q * 8 + 2 * e] = bflo(v[e]); hx[q * 8 + 2 * e + 1] = bfhi(v[e]); }
    }
  }
#pragma unroll
  for (int e = 0; e < 32; ++e) acc[e] = 0.f;
  const int e0 = p.eidx[(size_t)tok * 128 + lane], e1 = p.eidx[(size_t)tok * 128 + 64 + lane];
  const int g0 = __builtin_bit_cast(int, p.gw[(size_t)tok * 128 + lane]), g1 = __builtin_bit_cast(int, p.gw[(size_t)tok * 128 + 64 + lane]);
  u32x2 dn[4][3], up[4][3];
  auto issue = [&](int k, int slot) {
    const int e = (k < 64) ? __builtin_amdgcn_readlane(e0, k) : __builtin_amdgcn_readlane(e1, k - 64);
    const unsigned char* dr = p.down8 + (size_t)e * ROW6 + lane * 24;
    const unsigned char* ur = p.up8 + (size_t)e * ROW6 + lane * 24;
#pragma unroll
    for (int i = 0; i < 3; ++i) { dn[slot][i] = *(const u32x2*)(dr + i * 8); up[slot][i] = *(const u32x2*)(ur + i * 8); }
  };
  issue(0, 0); issue(1, 1); issue(2, 2);
#pragma unroll 1
  for (int k4 = 0; k4 < 128; k4 += 4) {
#pragma unroll
    for (int s = 0; s < 4; ++s) {
      const int k = k4 + s;
      if (k + 3 < 128) issue(k + 3, (s + 3) & 3);
      const v6u dq = v6u{dn[s][0][0], dn[s][0][1], dn[s][1][0], dn[s][1][1], dn[s][2][0], dn[s][2][1]};
      const v32f dv = __builtin_amdgcn_cvt_scalef32_pk32_f32_fp6(dq, 1.0f);
      float d0 = 0.f, d1 = 0.f, d2 = 0.f, d3 = 0.f;
#pragma unroll
      for (int i = 0; i < 8; ++i) { d0 += dv[4 * i] * hx[4 * i]; d1 += dv[4 * i + 1] * hx[4 * i + 1]; d2 += dv[4 * i + 2] * hx[4 * i + 2]; d3 += dv[4 * i + 3] * hx[4 * i + 3]; }
      const float d = wave_sum_fast((d0 + d1) + (d2 + d3)) * (1.f / DOWN_SCALE);
      const float gk = __builtin_bit_cast(float, (k < 64) ? __builtin_amdgcn_readlane(g0, k) : __builtin_amdgcn_readlane(g1, k - 64));
      const float act = gelu_exact(d) * gk * (1.f / UP_SCALE);
      const v6u uq = v6u{up[s][0][0], up[s][0][1], up[s][1][0], up[s][1][1], up[s][2][0], up[s][2][1]};
      const v32f uv = __builtin_amdgcn_cvt_scalef32_pk32_f32_fp6(uq, 1.0f);
#pragma unroll
      for (int i = 0; i < 32; ++i) acc[i] += act * uv[i];
    }
  }
  const float* gt2 = p.mod + (size_t)b * 12288 + 10240;
  float* orow = p.out + (size_t)tok * 2048;
#pragma unroll
  for (int q = 0; q < 8; ++q) {
    const int col = lane * 32 + q * 4;
    float4 x0 = *(const float4*)(orow + col);
    float4 ga = *(const float4*)(gt2 + col);
    x0.x += ga.x * acc[q * 4 + 0]; x0.y += ga.y * acc[q * 4 + 1]; x0.z += ga.z * acc[q * 4 + 2]; x0.w += ga.w * acc[q * 4 + 3];
    *(float4*)(orow + col) = x0;
  }
}

#define XB_TMO      128
#define XB_XCNT(j)  (256  + 64 * (j))
#define XB_XSUB(j)  (1280 + 64 * (j))
#define XB_XGEN(j)  (2304 + 64 * (j))
#define XB_TOP      3328
#define XB_TOPGEN   3392
#define XCD_BAR_WORDS 3456
#define XB_SPIN_CAP (1u << 20)
DEV unsigned xb_ld(unsigned* p) { return __hip_atomic_load(p, __ATOMIC_RELAXED, __HIP_MEMORY_SCOPE_AGENT); }
DEV unsigned xb_add(unsigned* p, unsigned v) { return __hip_atomic_fetch_add(p, v, __ATOMIC_RELAXED, __HIP_MEMORY_SCOPE_AGENT); }
DEV unsigned xb_xcc_id() { return (unsigned)__builtin_amdgcn_s_getreg((3 << 11) | 20) & 0xFu; }
#define XB_SPIN(cond, bar) do { unsigned _sp = 0; while (cond) { __builtin_amdgcn_s_sleep(1); \
    if ((++_sp & 255u) == 0u) { if (xb_ld(&(bar)[XB_TMO])) break; if (_sp > XB_SPIN_CAP) { atomicAdd(&(bar)[XB_TMO], 1u); break; } } } } while (0)

DEV void xcd_barrier_complete(unsigned* bar, unsigned x, unsigned& nloc, unsigned& nx) {
  const unsigned G = gridDim.x;
  unsigned sum, cnt, mine, sp = 0u;
  for (;;) {
    sum = 0u; cnt = 0u; mine = 0u;
#pragma unroll
    for (unsigned j = 0; j < 16; ++j) { const unsigned c = xb_ld(&bar[XB_XCNT(j)]); sum += c; cnt += (c > 0u) ? 1u : 0u; mine = (j == x) ? c : mine; }
    if (sum == G) break;
    __builtin_amdgcn_s_sleep(1);
    if ((++sp & 255u) == 0u) { if (xb_ld(&bar[XB_TMO])) break; if (sp > XB_SPIN_CAP) { atomicAdd(&bar[XB_TMO], 1u); break; } }
  }
  nloc = mine > 0u ? mine : 1u; nx = cnt > 0u ? cnt : 1u;
}
DEV void xcd_barrier(unsigned* bar, unsigned x, volatile unsigned* st) {
  asm volatile("s_waitcnt vmcnt(0)" ::: "memory");
  __syncthreads();
  if (threadIdx.x == 0) {
    __builtin_amdgcn_s_waitcnt(0);
    unsigned nloc = st[0], nx = st[1];
    if (nloc == 0u) { xcd_barrier_complete(bar, x, nloc, nx); st[0] = nloc; st[1] = nx; }
    const unsigned old = xb_add(&bar[XB_XSUB(x)], 1u);
    const unsigned gen = old / nloc;
    if (old + 1u == (gen + 1u) * nloc) {
      __builtin_amdgcn_fence(__ATOMIC_RELEASE, "agent");
      asm volatile("s_waitcnt vmcnt(0)" ::: "memory");
      const unsigned og = xb_add(&bar[XB_TOP], 1u);
      const unsigned tg = og / nx;
      if (og + 1u == (tg + 1u) * nx) xb_add(&bar[XB_TOPGEN], 1u);
      else XB_SPIN(xb_ld(&bar[XB_TOPGEN]) == tg, bar);
      __builtin_amdgcn_fence(__ATOMIC_ACQUIRE, "agent");
      xb_add(&bar[XB_XGEN(x)], 1u);
      asm volatile("s_waitcnt vmcnt(0)" ::: "memory");
    } else {
      XB_SPIN(xb_ld(&bar[XB_XGEN(x)]) == gen, bar);
      __builtin_amdgcn_fence(__ATOMIC_ACQUIRE, "agent");
      asm volatile("s_waitcnt vmcnt(0)" ::: "memory");
    }
  }
  __syncthreads();
}

__global__ void __launch_bounds__(256, 2) fwd_megakernel(Params p) {
  __shared__ __attribute__((aligned(16))) char smem[SMEM_BYTES];
  const int nb = gridDim.x, bid = blockIdx.x;
  __shared__ uint4 xb_words;
  if (threadIdx.x == 0) xb_words = make_uint4(0u, 0u, 0u, 0u);
  __syncthreads();
  const unsigned xcc = xb_xcc_id();
  if (threadIdx.x == 0) (void)xb_add(&p.bar[XB_XCNT(xcc)], 1u);
  volatile unsigned* xb_st = (volatile unsigned*)&xb_words;
  float* smf = (float*)smem;
#define FRESH_TID() int tid = threadIdx.x; asm volatile("" : "+v"(tid)); const int wid = tid >> 6; (void)wid;

  {
    FRESH_TID();
  {
    const int n_mod = 384, n_tin = 32 * 74, n_tout = 1024, n_tq = 1024, n_tck = 128, n_tcv = 128, n_cb = 2, n_g = 128, n_rt = 512, n_kb = 128;
    const int total = n_mod + n_tin + n_tout + n_tq + n_tck + n_tcv + n_cb + n_g + n_rt + n_kb;
    for (int it = bid; it < total; it += nb) {
      int i = it;
      if (i < n_mod) { ph_modpart(p, i, smf); continue; }
      i -= n_mod;
      if (i < n_tin) { ph_transpose(p.w_in, 2048, NIN, ZLD, p.Wt_in, i, smf); continue; }
      i -= n_tin;
      if (i < n_tout) { ph_transpose(p.w_out, 2048, 2048, 2048, p.Wt_out, i, smf); continue; }
      i -= n_tout;
      if (i < n_tq) { ph_transpose(p.peer_wq, 2048, 2048, 2048, p.Wt_q, i, smf); continue; }
      i -= n_tq;
      if (i < n_tck) { ph_transpose(p.cmp_w_k, 4096, 128, 128, p.Wt_ck, i, smf); continue; }
      i -= n_tck;
      if (i < n_tcv) { ph_transpose(p.cmp_w_v, 4096, 128, 128, p.Wt_cv, i, smf); continue; }
      i -= n_tcv;
      if (i < n_cb) { for (int e = tid; e < 4096; e += 256) p.pe_b[i * 4096 + e] = f2bf((i ? p.cmp_pe_v : p.cmp_pe_k)[e]); continue; }
      i -= n_cb;
      if (i >= n_g + n_rt) {
        const int e0 = (i - n_g - n_rt) * 2048 + tid * 8;
        float4 a0 = *(const float4*)(p.peer_keys + e0), a1 = *(const float4*)(p.peer_keys + e0 + 4);
        u32x4 o; o[0] = pack2(a0.x, a0.y); o[1] = pack2(a0.z, a0.w); o[2] = pack2(a1.x, a1.y); o[3] = pack2(a1.z, a1.w);
        *(u32x4*)(p.keys_b + e0) = o;
        continue;
      }
      if (i >= n_g) {
        const int e = (i - n_g) * 256 + tid, pos = e >> 6, d = e & 63;
        const float freq = exp2f(-(float)d * (13.287712379549449f / 64.f));
        float sn, cs;
        sincosf((float)pos * freq, &sn, &cs);
        p.rope_tab[(size_t)e * 2] = cs; p.rope_tab[(size_t)e * 2 + 1] = sn;
        continue;
      }
      {
        for (int e = i * 2048 + tid; e < (i + 1) * 2048; e += 256) {
          int d = e & 127, jr = (e >> 7) & 255, n = e >> 15;
          int hf = jr >> 7, j = jr & 127, wc = j >> 6, nn = (j >> 4) & 3, fr = j & 15;
          int chl = hf * 64 + wc * 32 + (nn & 1) * 16 + fr;
          const float* src = (nn >> 1) ? p.lru_wi : p.lru_wa;
          p.Wt_g[e] = f2bf(src[((size_t)n * 128 + d) * 128 + chl]);
        }
      }
    }
  }
  }
  xcd_barrier(p.bar, xcc, xb_st);
  {
    FRESH_TID();
  for (int e = bid * 256 + tid; e < 8 * 12288; e += nb * 256) {
    int b = e / 12288, n = e % 12288;
    float s = p.ada_b[n];
    for (int kc = 0; kc < 32; ++kc) s += p.modpart[((size_t)(kc * 8 + b)) * 12288 + n];
    p.mod[e] = s;
  }
  }
  xcd_barrier(p.bar, xcc, xb_st);
  {
    FRESH_TID();
  for (int row = bid * 4 + wid; row < T_; row += nb * 4) ph_adaln_row(p.x, p.norm_mix_g, p.mod, 0, 2048, p.h, row);
  }
  xcd_barrier(p.bar, xcc, xb_st);
  {
    FRESH_TID();
  for (int jt = (bid >> 3); jt < 8 * 37; jt += (nb >> 3)) {
    const int pn = jt >> 3, pm = (bid & 7) * 8 + (jt & 7);
    const u16* A = p.h + (size_t)pm * 256 * 2048;
    gemm_tile256([&](int r, int k) { return A + (size_t)r * 2048 + k; }, p.Wt_in + (size_t)pn * 128 * 2048, 2048, 2048,
              [&](auto&& stager, int h) {
                const int pme = pm * 2 + h;
                stager(smf, 129);
                const int t2 = ltid(), r = t2 >> 1, hf = t2 & 1;
                const int tok = pme * 128 + r;
                float* gcol = smf + 128 * 129;
                int kind = 0; const float* gn = nullptr; float osc = 1.f; u16* vT = nullptr;
                if (pn < 8) { kind = 1; gn = p.q_norm_g; osc = QSCALE; }
                else if (pn < 10) { kind = 2; }
                else if (pn < 12) { kind = 0; }
                else if (pn < 14) { kind = 1; gn = p.k_norm_g + 128; }
                else if (pn < 16) { kind = 3; vT = p.vsT + (size_t)(((pme >> 4) * 2 + (pn - 14)) * 128) * S_; }
                else if (pn < 18) { kind = 1; gn = p.k_norm_g + 256; }
                else if (pn < 20) { kind = 3; vT = p.vwT + (size_t)(((pme >> 4) * 2 + (pn - 18)) * 128) * S_; }
                if (t2 < 128) gcol[t2] = (kind == 1) ? gn[t2] : 1.f;
                __syncthreads();
                if (kind == 0) {
                  store_row_bf16(smf + r * 129 + hf * 64, p.z + (size_t)tok * ZLD + pn * 128 + hf * 64);
                } else if (kind == 3) {
                  const int t0 = (pme & 15) * 128 + hf * 64;
                  u16* dst = vT + (size_t)r * S_ + t0;
#pragma unroll
                  for (int q = 0; q < 8; ++q) {
                    u32x4 o;
#pragma unroll
                    for (int e = 0; e < 4; ++e) o[e] = pack2(smf[(hf * 64 + q * 8 + 2 * e) * 129 + r], smf[(hf * 64 + q * 8 + 2 * e + 1) * 129 + r]);
                    *(u32x4*)(dst + q * 8) = o;
                  }
                } else {
                  const int lane2 = t2 & 63, w2 = t2 >> 6;
                  const float g1 = gcol[lane2], g2 = gcol[64 + lane2];
                  const float* tabw = p.rope_tab + ((size_t)((pme * 128 + w2 * 32) & 2047) * 64 + lane2) * 2;
                  u16* dstw = p.z + (size_t)(pme * 128 + w2 * 32) * ZLD + pn * 128 + lane2;
#pragma unroll 1
                  for (int r8 = 0; r8 < 32; r8 += 8) {
                  float2 csr[8];
#pragma unroll
                  for (int rr = 0; rr < 8; ++rr) csr[rr] = *(const float2*)(tabw + (size_t)(r8 + rr) * 128);
#pragma unroll
                  for (int r1 = 0; r1 < 8; ++r1) {
                    const int rr = r8 + r1;
                    const float* sr2 = smf + (w2 * 32 + rr) * 129;
                    float x1 = sr2[lane2], x2 = sr2[64 + lane2];
                    const float2 cs2 = csr[r1];
                    float sc = osc;
                    if (kind == 1) {
                      const float ss = wave_sum_fast(x1 * x1 + x2 * x2);
                      sc = rsqrtf(ss * (1.f / 128.f) + 1e-6f) * osc;
                    }
                    x1 *= sc * g1; x2 *= sc * g2;
                    dstw[(size_t)rr * ZLD] = f2bf(x1 * cs2.x - x2 * cs2.y);
                    dstw[(size_t)rr * ZLD + 64] = f2bf(x2 * cs2.x + x1 * cs2.y);
                  }
                  }
                }
                __syncthreads();
              }, smem);
  }
  }
  xcd_barrier(p.bar, xcc, xb_st);
  {
    FRESH_TID();
  for (int t8 = bid * 4 + wid; t8 < T_ / 8; t8 += nb * 4) ph_conv_tokens(p, t8 * 8);
  for (int it = nb - 1 - bid; it < 128; it += nb) {
        const int ks = it & 3, tile = it >> 2, which = tile >> 4, bg = tile & 15, b = bg >> 1, g = bg & 1;
        const u16* zbase = p.z + (size_t)(b * S_) * ZLD + (which ? CVC : CKC) + g * 128;
        const u16* peb = p.pe_b + which * 4096 + ks * 1024;
        float* cp = p.cpart + (size_t)it * 128 * 128;
        gemm_tile([&](int r, int k) { return r < 127 ? zbase + (size_t)(16 * r + ks * 8 + (k >> 7)) * ZLD + (k & 127) : peb + k; },
                  (which ? p.Wt_cv : p.Wt_ck) + ks * 1024, 4096, 1024,
                  [&](f32x4 (&acc)[4][4], int wr, int wc, int fr, int fq) {
#pragma unroll
                    for (int m = 0; m < 4; ++m)
#pragma unroll
                      for (int n = 0; n < 4; ++n)
#pragma unroll
                        for (int j = 0; j < 4; ++j) cp[(wr * 64 + m * 16 + fq * 4 + j) * 128 + wc * 64 + n * 16 + fr] = acc[m][n][j];
                  }, smem);
  }
  }
  xcd_barrier(p.bar, xcc, xb_st);
  {
    FRESH_TID();
  {
  for (int tile = bid; tile < 32; tile += nb) {
    const int which = tile >> 4, bg = tile & 15;
    const float* cp = p.cpart + (size_t)tile * 4 * 128 * 128;
    __syncthreads();
    for (int e = tid; e < 128 * 32; e += 256) {
      const int r = e >> 5, c4 = e & 31;
      float4 v = *(const float4*)(cp + (size_t)r * 128 + c4 * 4);
#pragma unroll
      for (int ks = 1; ks < 4; ++ks) {
        float4 w = *(const float4*)(cp + (size_t)ks * 16384 + (size_t)r * 128 + c4 * 4);
        v.x += w.x; v.y += w.y; v.z += w.z; v.w += w.w;
      }
      smf[r * 129 + c4 * 4] = v.x; smf[r * 129 + c4 * 4 + 1] = v.y; smf[r * 129 + c4 * 4 + 2] = v.z; smf[r * 129 + c4 * 4 + 3] = v.w;
    }
    __syncthreads();
    const int rr = tid & 127, hf = tid >> 7;
    if (!which) {
      float ss = 0.f;
      for (int c = 0; c < 128; ++c) { float v = smf[rr * 129 + c] + smf[127 * 129 + c]; ss += v * v; }
      float rs = rsqrtf(ss * (1.f / 128.f) + 1e-6f);
      if (rr == 127) rs = 0.f;
      for (int c = hf * 64; c < hf * 64 + 64; ++c) p.kcmp[((size_t)bg * 128 + rr) * 128 + c] = f2bf((smf[rr * 129 + c] + smf[127 * 129 + c]) * rs * p.k_norm_g[c]);
    } else {
      for (int r = hf * 64; r < hf * 64 + 64; ++r) p.vcT[((size_t)bg * 128 + rr) * 128 + r] = (r == 127) ? (u16)0 : f2bf(smf[r * 129 + rr] + smf[127 * 129 + rr]);
    }
  }
    const int n_c = 0, n_gate = 2048;
    for (int it = bid; it < n_c + n_gate; it += nb) {
      {
        const int i = it - n_c, hf = i & 1, n = (i >> 1) & 7, mt = i >> 4;
        const u16* A = p.U + (size_t)mt * 128 * 1024 + n * 128;
        gemm_tile([&](int r, int k) { return A + (size_t)r * 1024 + k; }, p.Wt_g + (size_t)((n * 2 + hf) * 128) * 128, 128, 128,
                  [&](f32x4 (&acc)[4][4], int wr, int wc, int fr, int fq) {
#pragma unroll
                    for (int nn = 0; nn < 2; ++nn) {
                      const int ch = n * 128 + hf * 64 + wc * 32 + nn * 16 + fr;
                      const float ba = p.lru_ba[ch], bi = p.lru_bi[ch], lam = p.lru_lam[ch];
                      const float sp = log1pf(__expf(-lam));
#pragma unroll
                      for (int m = 0; m < 4; ++m)
#pragma unroll
                        for (int j = 0; j < 4; ++j) {
                          const size_t t = (size_t)mt * 128 + wr * 64 + m * 16 + fq * 4 + j;
                          float r = sigmoidf_(acc[m][nn][j] + ba), ig = sigmoidf_(acc[m][nn + 2][j] + bi);
                          float la = -8.f * r * sp;
                          float a = __expf(la);
                          float u = bf2f(p.U[t * 1024 + ch]);
                          float bb = sqrtf(fmaxf(-expm1f(2.f * la), 0.f)) * ig * u;
                          const int rl = wr * 64 + m * 16 + fq * 4 + j, cl = wc * 32 + nn * 16 + fr;
                          smf[rl * 68 + cl] = a; smf[8704 + rl * 68 + cl] = bb;
                        }
                    }
                    __syncthreads();
                    {
                      const int t3 = ltid(), c4 = t3 & 15, r0 = t3 >> 4;
                      const size_t gbase = ((size_t)mt * 128) * 1024 + n * 128 + hf * 64 + c4 * 4;
#pragma unroll 4
                      for (int ps = 0; ps < 8; ++ps) {
                        const int r = ps * 16 + r0;
                        *(float4*)(p.a_arr + gbase + (size_t)r * 1024) = *(const float4*)(smf + r * 68 + c4 * 4);
                        *(float4*)(p.b_arr + gbase + (size_t)r * 1024) = *(const float4*)(smf + 8704 + r * 68 + c4 * 4);
                      }
                    }
                    __syncthreads();
                  }, smem);
      }
    }
  }
  }
  xcd_barrier(p.bar, xcc, xb_st);
  {
    FRESH_TID();
  {
    const int n_attn = 1024, n_s1 = B_ * NCH;
    if (nb == 512) {
      const int x = bid & 7, l = bid >> 3, bg = 2 * x + (l & 1), k = l >> 1;
      attn_item(p, (k << 4) | bg, smem);
      attn_item(p, ((63 - k) << 4) | bg, smem);
      ph_scan1(p, bid);
    } else {
      for (int it = bid; it < n_attn + n_s1; it += nb) {
        if (it < n_attn) attn_item(p, it, smem);
        else ph_scan1(p, it - n_attn);
      }
    }
  }
  }
  xcd_barrier(p.bar, xcc, xb_st);
  {
    FRESH_TID();
  for (int it = bid; it < B_ * NCH; it += nb) ph_scan2(p, it);
  }
  xcd_barrier(p.bar, xcc, xb_st);
  {
    FRESH_TID();
  for (int row = bid * 4 + wid; row < T_; row += nb * 4) ph_ynorm_row(p, row);
  }
  xcd_barrier(p.bar, xcc, xb_st);
  {
    FRESH_TID();
  for (int jt = (bid >> 3); jt < 8 * 16; jt += (nb >> 3)) {
    const int pn = jt >> 3, pm = (bid & 7) * 8 + (jt & 7), b = pm >> 3;
    const u16* A = p.y + (size_t)pm * 256 * 2048;
    const float* gt1 = p.mod + (size_t)b * 12288 + 4096 + pn * 128;
    gemm_tile256([&](int r, int k) { return A + (size_t)r * 2048 + k; }, p.Wt_out + (size_t)pn * 128 * 2048, 2048, 2048,
              [&](auto&& stager, int h) {
                const float* xin = p.x + (size_t)(pm * 2 + h) * 128 * 2048 + pn * 128;
                float* ot = p.out + (size_t)(pm * 2 + h) * 128 * 2048 + pn * 128;
                stager(smf, 132);
                __syncthreads();
                const int t2 = ltid(), c4 = t2 & 31, r0 = t2 >> 5;
                const float4 g = *(const float4*)(gt1 + c4 * 4);
#pragma unroll 4
                for (int ps = 0; ps < 16; ++ps) {
                  const int r = ps * 8 + r0;
                  const float4 sv = *(const float4*)(smf + r * 132 + c4 * 4);
                  float4 xv = *(const float4*)(xin + (size_t)r * 2048 + c4 * 4);
                  xv.x += g.x * sv.x; xv.y += g.y * sv.y; xv.z += g.z * sv.z; xv.w += g.w * sv.w;
                  *(float4*)(ot + (size_t)r * 2048 + c4 * 4) = xv;
                }
                __syncthreads();
              }, smem);
  }
  }
  xcd_barrier(p.bar, xcc, xb_st);
  {
    FRESH_TID();
  for (int row = bid * 4 + wid; row < T_; row += nb * 4) ph_adaln_row(p.out, p.norm_ffn_g, p.mod, 6144, 8192, p.h, row);
  }
  xcd_barrier(p.bar, xcc, xb_st);
  {
    FRESH_TID();
  for (int jt = (bid >> 3); jt < 8 * 16; jt += (nb >> 3)) {
    const int pn = jt >> 3, pm = (bid & 7) * 8 + (jt & 7);
    const u16* A = p.h + (size_t)pm * 256 * 2048;
    gemm_tile256([&](int r, int k) { return A + (size_t)r * 2048 + k; }, p.Wt_q + (size_t)pn * 128 * 2048, 2048, 2048,
              [&](auto&& stager, int h) {
                u16* ot = p.pq + (size_t)(pm * 2 + h) * 128 * 2048 + pn * 128;
                stager(smf, 132);
                __syncthreads();
                const int t2 = ltid(), c8 = t2 & 15, r0 = t2 >> 4;
#pragma unroll 4
                for (int ps = 0; ps < 8; ++ps) {
                  const int r = ps * 16 + r0;
                  const float4 s0 = *(const float4*)(smf + r * 132 + c8 * 8), s1 = *(const float4*)(smf + r * 132 + c8 * 8 + 4);
                  u32x4 o; o[0] = pack2(s0.x, s0.y); o[1] = pack2(s0.z, s0.w); o[2] = pack2(s1.x, s1.y); o[3] = pack2(s1.z, s1.w);
                  *(u32x4*)(ot + (size_t)r * 2048 + c8 * 8) = o;
                }
                __syncthreads();
              }, smem);
  }
  }
  xcd_barrier(p.bar, xcc, xb_st);
  {
    FRESH_TID();
  if (bid < (nb >> 1)) {
  for (size_t blk = (size_t)bid * 256 + tid; blk < (size_t)16384 * 64; blk += (size_t)nb * 256) {
#pragma unroll
    for (int tb = 0; tb < 2; ++tb) {
      const float* src = (tb ? p.peer_up : p.peer_down) + blk * 32;
      const float sc = tb ? UP_SCALE : DOWN_SCALE;
      v16f va, vb;
#pragma unroll
      for (int q = 0; q < 4; ++q) {
        const float4 x = *(const float4*)(src + q * 8), y = *(const float4*)(src + q * 8 + 4);
        va[q * 4] = x.x * sc; vb[q * 4] = x.y * sc; va[q * 4 + 1] = x.z * sc; vb[q * 4 + 1] = x.w * sc;
        va[q * 4 + 2] = y.x * sc; vb[q * 4 + 2] = y.y * sc; va[q * 4 + 3] = y.z * sc; vb[q * 4 + 3] = y.w * sc;
      }
      const v6u o = __builtin_amdgcn_cvt_scalef32_2xpk16_fp6_f32(va, vb, 1.0f);
      unsigned char* dst = (tb ? p.up8 : p.down8) + blk * 24;
      *(u32x2*)dst = u32x2{o[0], o[1]}; *(u32x2*)(dst + 8) = u32x2{o[2], o[3]}; *(u32x2*)(dst + 16) = u32x2{o[4], o[5]};
    }
  }
  }
  for (int it = bid; it < 8 * 256; it += nb) peer_route_item(p, it, smem);
  if (bid >= (nb >> 1)) {
  for (size_t blk = (size_t)bid * 256 + tid; blk < (size_t)16384 * 64; blk += (size_t)nb * 256) {
#pragma unroll
    for (int tb = 0; tb < 2; ++tb) {
      const float* src = (tb ? p.peer_up : p.peer_down) + blk * 32;
      const float sc = tb ? UP_SCALE : DOWN_SCALE;
      v16f va, vb;
#pragma unroll
      for (int q = 0; q < 4; ++q) {
        const float4 x = *(const float4*)(src + q * 8), y = *(const float4*)(src + q * 8 + 4);
        va[q * 4] = x.x * sc; vb[q * 4] = x.y * sc; va[q * 4 + 1] = x.z * sc; vb[q * 4 + 1] = x.w * sc;
        va[q * 4 + 2] = y.x * sc; vb[q * 4 + 2] = y.y * sc; va[q * 4 + 3] = y.z * sc; vb[q * 4 + 3] = y.w * sc;
      }
      const v6u o = __builtin_amdgcn_cvt_scalef32_2xpk16_fp6_f32(va, vb, 1.0f);
      unsigned char* dst = (tb ? p.up8 : p.down8) + blk * 24;
      *(u32x2*)dst = u32x2{o[0], o[1]}; *(u32x2*)(dst + 8) = u32x2{o[2], o[3]}; *(u32x2*)(dst + 16) = u32x2{o[4], o[5]};
    }
  }
  }
  }
  xcd_barrier(p.bar, xcc, xb_st);
  {
    FRESH_TID();
  for (int tok = bid * 4 + wid; tok < T_; tok += nb * 4) peer_gather_token(p, tok);
  }
}

extern "C" void kernel_launch(void* const* d_in, const int* in_sizes, int n_in, void* d_out, int out_size, void* d_ws, size_t ws_size,
                              hipStream_t stream) {
  static int grid_blocks = 0;
  if (!grid_blocks) {
    int dev = 0, cus = 0, per_cu = 0;
    (void)hipGetDevice(&dev);
    (void)hipDeviceGetAttribute(&cus, hipDeviceAttributeMultiprocessorCount, dev);
    (void)hipOccupancyMaxActiveBlocksPerMultiprocessor(&per_cu, fwd_megakernel, 256, 0);
    if (per_cu > 2) per_cu = 2;
    if (per_cu < 1) per_cu = 1;
    grid_blocks = cus * per_cu;
  }
  Params p{};
  const float* const* in = (const float* const*)d_in;
  p.x = in[0]; p.c = in[1]; p.ada_w = in[2]; p.ada_b = in[3]; p.norm_mix_g = in[4]; p.norm_ffn_g = in[5]; p.w_in = in[6]; p.w_out = in[7];
  p.q_norm_g = in[8]; p.k_norm_g = in[9]; p.cmp_pe_k = in[10]; p.cmp_pe_v = in[11]; p.cmp_w_k = in[12]; p.cmp_w_v = in[13]; p.gate_b = in[14];
  p.conv_w = in[15]; p.conv_b = in[16]; p.lru_wa = in[17]; p.lru_ba = in[18]; p.lru_wi = in[19]; p.lru_bi = in[20]; p.lru_lam = in[21];
  p.out_g_attn = in[22]; p.out_g_rnn = in[23]; p.peer_wq = in[24]; p.peer_keys = in[25]; p.peer_down = in[26]; p.peer_up = in[27];
  p.out = (float*)d_out;
  char* ws = (char*)d_ws;
  size_t off = 0;
  auto take = [&](size_t bytes) { char* r = ws + off; off += (bytes + 255) & ~(size_t)255; return r; };
  p.Wt_in = (u16*)take((size_t)ZLD * 2048 * 2);
  p.Wt_out = (u16*)take((size_t)2048 * 2048 * 2);
  p.Wt_q = (u16*)take((size_t)2048 * 2048 * 2);
  p.Wt_ck = (u16*)take((size_t)128 * 4096 * 2);
  p.Wt_cv = (u16*)take((size_t)128 * 4096 * 2);
  p.Wt_g = (u16*)take((size_t)8 * 256 * 128 * 2);
  p.cbias = (float*)take(256 * 4);
  p.modpart = (float*)take((size_t)32 * 8 * 12288 * 4);
  p.mod = (float*)take((size_t)8 * 12288 * 4);
  p.h = (u16*)take((size_t)T_ * 2048 * 2);
  (void)take((size_t)T_ * 1024 * 2);
  p.oattn3 = p.h;
  p.z = (u16*)take((size_t)T_ * ZLD * 2);
  p.vsT = (u16*)take((size_t)16 * 128 * S_ * 2);
  p.vwT = (u16*)take((size_t)16 * 128 * S_ * 2);
  p.vcT = (u16*)take((size_t)16 * 128 * 128 * 2);
  p.kcmp = (u16*)take((size_t)16 * 128 * 128 * 2);
  p.U = (u16*)take((size_t)T_ * 1024 * 2);
  p.a_arr = (float*)take((size_t)T_ * 1024 * 4);
  p.b_arr = (float*)take((size_t)T_ * 1024 * 4);
  p.csA = (float*)take((size_t)B_ * NCH * 1024 * 4);
  p.csH = (float*)take((size_t)B_ * NCH * 1024 * 4);
  p.bar = (unsigned*)take(XCD_BAR_WORDS * 4);
  p.rope_tab = (float*)take((size_t)2048 * 64 * 2 * 4);
  p.pe_b = (u16*)take((size_t)2 * 4096 * 2);
  p.cpart = (float*)take((size_t)128 * 128 * 128 * 4);
  p.keys_b = (u16*)take((size_t)16 * 128 * 128 * 2);
  p.orn = p.U;
  p.y = (u16*)p.a_arr;
  p.pq = (u16*)p.b_arr;
  p.down8 = (unsigned char*)p.z;
  p.up8 = (unsigned char*)p.z + (size_t)16384 * 1536;
  p.eidx = (int*)p.U;
  p.gw = (float*)(p.U + (size_t)T_ * 128 * 2);
  if (off > ws_size) fprintf(stderr, "workspace too small: need %zu have %zu\n", off, ws_size);
  (void)hipMemsetAsync(p.bar, 0, XCD_BAR_WORDS * 4, stream);
  void* args[] = {&p};
  hipError_t e = hipLaunchCooperativeKernel((void*)fwd_megakernel, dim3(grid_blocks), dim3(256), args, 0, stream);
  if (e != hipSuccess) fprintf(stderr, "cooperative launch failed: %s (grid %d)\n", hipGetErrorString(e), grid_blocks);
}
```
